# Optimizing an MI355X kernel written in HIP

```python
import math
import functools
import jax
import jax.numpy as jnp
from jax import lax
import numpy as np

D_MODEL = 1024
BATCH = 8
SEQ = 2048
DEPTH = 2

HEAD_DIM = 64
D_FF = 2816
MACARON_WEIGHT = 0.5
NORM_EPS = 1e-6
QBLK = 128
GATHER_QBLK = 16
NEG_INF = -1e30
FORCE_SCORE = 1e9

REL_BUCKETS = 32
REL_MAX_DIST = 1024
A_SLOT = 0
C_SLOT = 8
D_SLOT = 16
REL_SLOTS = 24

A_HEADS = 8
A_KV_HEADS = 2
A_WINDOW = 128

B_HEADS = 8
MLA_Q_RANK = 256
MLA_KV_RANK = 128
MLA_NOPE = 64
MLA_ROPE = 32
MLA_V = 64
ROPE_THETA = 10000.0

C_HEADS = 8
C_KV_HEADS = 2
CMP_BLOCK = 32
CMP_STRIDE = 16
CMP_HIDDEN = 256
SEL_BLOCK = 64
SEL_TOPK = 8
NSA_WINDOW = 256

D_HEADS = 8
MOBA_BLOCK = 256
MOBA_TOPK = 3

AB_COLS = (A_HEADS * HEAD_DIM, A_KV_HEADS * HEAD_DIM, A_KV_HEADS * HEAD_DIM, MLA_Q_RANK, MLA_KV_RANK, MLA_ROPE)
CD_COLS = (C_HEADS * HEAD_DIM,) + (C_KV_HEADS * HEAD_DIM,) * 6 + (3 * C_HEADS,) + (D_HEADS * HEAD_DIM,) * 3
AB_OUT = A_HEADS * HEAD_DIM + B_HEADS * MLA_V
CD_OUT = C_HEADS * HEAD_DIM + D_HEADS * HEAD_DIM

kernel_name = 'hybrid_swa_mla_nsa_moba_macaron'


def split_cols(z, sizes):
    return jnp.split(z, np.cumsum(sizes)[:-1].tolist(), axis=-1)


def rms_norm(x, g):
    xf = x.astype(jnp.float32)
    y = xf * lax.rsqrt(jnp.mean(xf * xf, axis=-1, keepdims=True) + NORM_EPS)
    return (y * g.astype(jnp.float32)).astype(x.dtype)


def swiglu(h, wg, wu, wd):
    return (jax.nn.silu(h @ wg) * (h @ wu)) @ wd


def sandwich(x, pre, post, fn, weight):
    return x + weight * rms_norm(fn(rms_norm(x, pre)), post)


def t5_bucket(dist):
    n = jnp.maximum(dist, 0)
    exact = REL_BUCKETS // 2
    nf = jnp.maximum(n, 1).astype(jnp.float32)
    large = exact + (jnp.log(nf / exact) / math.log(REL_MAX_DIST / exact) * (REL_BUCKETS - exact)).astype(jnp.int32)
    return jnp.where(n < exact, n, jnp.minimum(large, REL_BUCKETS - 1))


def rope_tables(S):
    inv = ROPE_THETA ** (-jnp.arange(0, MLA_ROPE, 2, dtype=jnp.float32) / MLA_ROPE)
    ang = jnp.arange(S, dtype=jnp.float32)[:, None] * inv[None, :]
    return jnp.cos(ang), jnp.sin(ang)


def apply_rope(x, cos, sin):
    x1, x2 = jnp.split(x, 2, axis=-1)
    return jnp.concatenate([x1 * cos - x2 * sin, x2 * cos + x1 * sin], axis=-1).astype(x.dtype)


def band_blocks(t, window):
    B, S = t.shape[:2]
    nb = S // QBLK
    tp = jnp.pad(t, [(0, 0), (window, 0)] + [(0, 0)] * (t.ndim - 2))
    parts = [tp[:, j * QBLK:j * QBLK + S].reshape((B, nb, QBLK) + t.shape[2:]) for j in range(window // QBLK + 1)]
    return jnp.concatenate(parts, axis=2)


def band_attention(q, k, v, window, bias_cols, sinks=None):
    B, S, Hkv, G, Dh = q.shape
    nb = S // QBLK
    span = window + QBLK
    qb = q.reshape(B, nb, QBLK, Hkv, G, Dh)
    kb = band_blocks(k, window)
    vb = band_blocks(v, window)
    kk = jnp.arange(span)[None, :]
    dist = jnp.arange(QBLK)[:, None] + window - kk
    kpos = jnp.arange(nb)[:, None, None] * QBLK - window + kk[None]
    valid = (dist >= 0) & (dist < window) & (kpos >= 0)
    bias = bias_cols.astype(jnp.float32)[t5_bucket(dist)].reshape(QBLK, span, Hkv, G).transpose(2, 3, 0, 1)
    s = jnp.einsum('bnqhgd,bnkhd->bnhgqk', qb, kb).astype(jnp.float32) * Dh ** -0.5 + bias
    s = jnp.where(valid[None, :, None, None], s, NEG_INF)
    if sinks is not None:
        sink = jnp.broadcast_to(sinks.astype(jnp.float32).reshape(Hkv, G, 1, 1), s.shape[:-1] + (1,))
        p = jax.nn.softmax(jnp.concatenate([s, sink], axis=-1), axis=-1)[..., :-1]
    else:
        p = jax.nn.softmax(s, axis=-1)
    o = jnp.einsum('bnhgqk,bnkhd->bnqhgd', p.astype(v.dtype), vb)
    return o.reshape(B, S, Hkv, G, -1)


def causal_block_attention(q, k, v):
    B, S, H, Dk = q.shape
    nb = S // QBLK
    kpos = jnp.arange(S)

    def block(args):
        qb, i = args
        qpos = i * QBLK + jnp.arange(QBLK)
        s = jnp.einsum('bqhd,bkhd->bhqk', qb, k).astype(jnp.float32) * Dk ** -0.5
        s = jnp.where(kpos[None, :] <= qpos[:, None], s, NEG_INF)
        p = jax.nn.softmax(s, axis=-1).astype(v.dtype)
        return jnp.einsum('bhqk,bkhd->bqhd', p, v)

    qs = q.reshape(B, nb, QBLK, H, Dk).swapaxes(0, 1)
    o = lax.map(block, (qs, jnp.arange(nb)))
    return o.swapaxes(0, 1).reshape(B, S, H, -1)


def gather_blocks(blocks, idx):
    return jax.vmap(jax.vmap(lambda b, i: b[i]))(blocks, idx)


def nsa_compressed(q, k, v, pe_k, pe_v, wk1, wk2, wv1, wv2):
    B, S, Hkv, G, Dh = q.shape
    n_c = (S - CMP_BLOCK) // CMP_STRIDE + 1
    starts = jnp.arange(n_c) * CMP_STRIDE
    cidx = starts[:, None] + jnp.arange(CMP_BLOCK)[None, :]

    def compress(t, pe, w1, w2):
        blk = t[:, cidx] + pe[None, None, :, None, :]
        blk = blk.transpose(0, 1, 3, 2, 4).reshape(B, n_c, Hkv, CMP_BLOCK * Dh)
        return jax.nn.silu(blk @ w1) @ w2

    k_cmp = compress(k, pe_k, wk1, wk2)
    v_cmp = compress(v, pe_v, wv1, wv2)
    valid = (starts + CMP_BLOCK - 1)[None, :] <= jnp.arange(S)[:, None]
    s = jnp.einsum('bshgd,bchd->bhgsc', q, k_cmp).astype(jnp.float32) * Dh ** -0.5
    p = jax.nn.softmax(jnp.where(valid, s, NEG_INF), axis=-1) * valid
    o = jnp.einsum('bhgsc,bchd->bshgd', p.astype(v_cmp.dtype), v_cmp)
    return o, p


def nsa_select(p_cmp, S):
    n_c = p_cmp.shape[-1]
    n_s = S // SEL_BLOCK
    c_start = jnp.arange(n_c)[:, None] * CMP_STRIDE
    j_start = jnp.arange(n_s)[None, :] * SEL_BLOCK
    overlap = ((c_start < j_start + SEL_BLOCK) & (c_start + CMP_BLOCK > j_start)).astype(jnp.float32)
    imp = jnp.einsum('bhgsc,cj->bhsj', p_cmp, overlap)
    cur = (jnp.arange(S) // SEL_BLOCK)[:, None]
    j = jnp.arange(n_s)[None, :]
    forced = (j == 0) | (j == cur) | (j == cur - 1)
    imp = jnp.where(forced, FORCE_SCORE, jnp.where(j <= cur, imp, NEG_INF))
    _, idx = lax.top_k(imp, min(SEL_TOPK, n_s))
    return idx


def nsa_selected(q, k, v, idx, bias_cols):
    B, S, Hkv, G, Dh = q.shape
    n_s = S // SEL_BLOCK
    top = idx.shape[-1]
    nq = S // GATHER_QBLK
    k_blk = k.reshape(B, n_s, SEL_BLOCK, Hkv, Dh).transpose(0, 3, 1, 2, 4)
    v_blk = v.reshape(B, n_s, SEL_BLOCK, Hkv, Dh).transpose(0, 3, 1, 2, 4)
    tab = bias_cols.astype(jnp.float32).reshape(REL_BUCKETS, Hkv, G).transpose(1, 0, 2)
    h_ix = jnp.arange(Hkv)[None, :, None, None, None]

    def block(args):
        qb, ib, i = args
        qpos = i * GATHER_QBLK + jnp.arange(GATHER_QBLK)
        kg = gather_blocks(k_blk, ib)
        vg = gather_blocks(v_blk, ib)
        dist = qpos[None, None, :, None, None] - (ib[..., None] * SEL_BLOCK + jnp.arange(SEL_BLOCK))
        bias = jnp.moveaxis(tab[h_ix, t5_bucket(dist)], -1, 2)
        s = jnp.einsum('bqhgd,bhqkld->bhgqkl', qb, kg).astype(jnp.float32) * Dh ** -0.5 + bias
        s = jnp.where(dist[:, :, None] >= 0, s, NEG_INF).reshape(B, Hkv, G, GATHER_QBLK, top * SEL_BLOCK)
        p = jax.nn.softmax(s, axis=-1).astype(vg.dtype).reshape(B, Hkv, G, GATHER_QBLK, top, SEL_BLOCK)
        return jnp.einsum('bhgqkl,bhqkld->bqhgd', p, vg)

    qs = q.reshape(B, nq, GATHER_QBLK, Hkv, G, Dh).swapaxes(0, 1)
    ids = idx.reshape(B, Hkv, nq, GATHER_QBLK, top).transpose(2, 0, 1, 3, 4)
    o = lax.map(block, (qs, ids, jnp.arange(nq)))
    return o.swapaxes(0, 1).reshape(B, S, Hkv, G, Dh)


def moba_attention(q, k, v, bias_cols):
    B, S, H, Dh = q.shape
    n_b = -(-S // MOBA_BLOCK)
    pad = n_b * MOBA_BLOCK - S
    kp = jnp.pad(k, ((0, 0), (0, pad), (0, 0), (0, 0)))
    vp = jnp.pad(v, ((0, 0), (0, pad), (0, 0), (0, 0)))
    k_blk = kp.reshape(B, n_b, MOBA_BLOCK, H, Dh)
    k_mean = jnp.mean(k_blk.astype(jnp.float32), axis=2)
    cur = (jnp.arange(S) // MOBA_BLOCK)[:, None]
    past = jnp.arange(n_b)[None, :] < cur
    gate = jnp.einsum('bshd,bnhd->bhsn', q.astype(jnp.float32), k_mean)
    top = min(MOBA_TOPK, n_b)
    _, idx = lax.top_k(jnp.where(past, gate, NEG_INF), top)
    k_bh = k_blk.transpose(0, 3, 1, 2, 4)
    v_bh = vp.reshape(B, n_b, MOBA_BLOCK, H, Dh).transpose(0, 3, 1, 2, 4)
    tab = bias_cols.astype(jnp.float32)
    tab_h = tab.T
    h_ix = jnp.arange(H)[None, :, None, None, None]
    nq = S // GATHER_QBLK
    scale = Dh ** -0.5

    def block(args):
        qb, ib, i = args
        qpos = i * GATHER_QBLK + jnp.arange(GATHER_QBLK)
        own = (i * GATHER_QBLK) // MOBA_BLOCK
        kg = gather_blocks(k_bh, ib)
        vg = gather_blocks(v_bh, ib)
        dist_sel = qpos[None, None, :, None, None] - (ib[..., None] * MOBA_BLOCK + jnp.arange(MOBA_BLOCK))
        s_sel = jnp.einsum('bqhd,bhqjld->bhqjl', qb, kg).astype(jnp.float32) * scale + tab_h[h_ix, t5_bucket(dist_sel)]
        s_sel = jnp.where((ib < own)[..., None], s_sel, NEG_INF).reshape(B, H, GATHER_QBLK, top * MOBA_BLOCK)
        k_own = lax.dynamic_slice_in_dim(kp, own * MOBA_BLOCK, MOBA_BLOCK, axis=1)
        v_own = lax.dynamic_slice_in_dim(vp, own * MOBA_BLOCK, MOBA_BLOCK, axis=1)
        dist_own = qpos[:, None] - (own * MOBA_BLOCK + jnp.arange(MOBA_BLOCK))[None, :]
        s_own = jnp.einsum('bqhd,bkhd->bhqk', qb, k_own).astype(jnp.float32) * scale + jnp.moveaxis(tab[t5_bucket(dist_own)], -1, 0)
        s_own = jnp.where(dist_own >= 0, s_own, NEG_INF)
        p = jax.nn.softmax(jnp.concatenate([s_sel, s_own], axis=-1), axis=-1).astype(v.dtype)
        p_sel = p[..., :top * MOBA_BLOCK].reshape(B, H, GATHER_QBLK, top, MOBA_BLOCK)
        p_own = p[..., top * MOBA_BLOCK:]
        return jnp.einsum('bhqjl,bhqjld->bqhd', p_sel, vg) + jnp.einsum('bhqk,bkhd->bqhd', p_own, v_own)

    qs = q.reshape(B, nq, GATHER_QBLK, H, Dh).swapaxes(0, 1)
    ids = idx.reshape(B, H, nq, GATHER_QBLK, top).transpose(2, 0, 1, 3, 4)
    o = lax.map(block, (qs, ids, jnp.arange(nq)))
    return o.swapaxes(0, 1).reshape(B, S, H, Dh)


def mixer_swa_mla(h, w_in, sinks, q_norm, w_uq, kv_norm, w_ukv, w_out, rel_table):
    B, S, _ = h.shape
    qa, ka, va, cq, ckv, kr = split_cols(h @ w_in, AB_COLS)
    kv_shape = (B, S, A_KV_HEADS, HEAD_DIM)
    qa = qa.reshape(B, S, A_KV_HEADS, A_HEADS // A_KV_HEADS, HEAD_DIM)
    o_a = band_attention(qa, ka.reshape(kv_shape), va.reshape(kv_shape), A_WINDOW,
                         rel_table[:, A_SLOT:A_SLOT + A_HEADS], sinks)
    q = (rms_norm(cq, q_norm) @ w_uq).reshape(B, S, B_HEADS, MLA_NOPE + MLA_ROPE)
    kv = (rms_norm(ckv, kv_norm) @ w_ukv).reshape(B, S, B_HEADS, MLA_NOPE + MLA_V)
    cos, sin = rope_tables(S)
    q = jnp.concatenate([q[..., :MLA_NOPE], apply_rope(q[..., MLA_NOPE:], cos[:, None], sin[:, None])], axis=-1)
    kr = apply_rope(kr, cos, sin)
    k = jnp.concatenate([kv[..., :MLA_NOPE], jnp.broadcast_to(kr[:, :, None, :], (B, S, B_HEADS, MLA_ROPE))], axis=-1)
    o_b = causal_block_attention(q, k, kv[..., MLA_NOPE:])
    o = jnp.concatenate([o_a.reshape(B, S, -1), o_b.reshape(B, S, -1)], axis=-1)
    return o @ w_out


def mixer_nsa_moba(h, w_in, pe_k, pe_v, wk1, wk2, wv1, wv2, w_out, rel_table):
    B, S, _ = h.shape
    G = C_HEADS // C_KV_HEADS
    qc, kc, vc, ks, vs, kw, vw, gl, qd, kd, vd = split_cols(h @ w_in, CD_COLS)
    kv_shape = (B, S, C_KV_HEADS, HEAD_DIM)
    qc = qc.reshape(B, S, C_KV_HEADS, G, HEAD_DIM)
    c_cols = rel_table[:, C_SLOT:C_SLOT + C_HEADS]
    o_cmp, p_cmp = nsa_compressed(qc, kc.reshape(kv_shape), vc.reshape(kv_shape), pe_k, pe_v, wk1, wk2, wv1, wv2)
    sel_idx = nsa_select(p_cmp, S)
    o_slc = nsa_selected(qc, ks.reshape(kv_shape), vs.reshape(kv_shape), sel_idx, c_cols)
    o_win = band_attention(qc, kw.reshape(kv_shape), vw.reshape(kv_shape), NSA_WINDOW, c_cols)
    g = jax.nn.sigmoid(gl).reshape(B, S, 3, C_KV_HEADS, G, 1)
    o_c = g[:, :, 0] * o_cmp + g[:, :, 1] * o_slc + g[:, :, 2] * o_win
    d_shape = (B, S, D_HEADS, HEAD_DIM)
    o_d = moba_attention(qd.reshape(d_shape), kd.reshape(d_shape), vd.reshape(d_shape),
                         rel_table[:, D_SLOT:D_SLOT + D_HEADS])
    o = jnp.concatenate([o_c.reshape(B, S, -1), o_d.reshape(B, S, -1)], axis=-1)
    return o @ w_out


def setup_inputs(seed: int = 0) -> dict:
    key = jax.random.key(seed)
    keys = iter(jax.random.split(key, 64))

    def normal(shape, scale):
        return scale * jax.random.normal(next(keys), shape, jnp.float32)

    def dense(fan_in, fan_out):
        return normal((fan_in, fan_out), fan_in ** -0.5)

    def gain(n):
        return 1.0 + normal((n,), 0.05)

    def add_ffn(d, prefix):
        d[prefix + '_pre'] = gain(D_MODEL)
        d[prefix + '_post'] = gain(D_MODEL)
        d[prefix + '_wg'] = dense(D_MODEL, D_FF)
        d[prefix + '_wu'] = dense(D_MODEL, D_FF)
        d[prefix + '_wd'] = dense(D_FF, D_MODEL)

    d = {}
    d['x'] = normal((BATCH, SEQ, D_MODEL), 1.0)
    d['rel_bias_table'] = normal((REL_BUCKETS, REL_SLOTS), 0.3)
    add_ffn(d, 'l0_ffn1')
    d['l0_mix_pre'] = gain(D_MODEL)
    d['l0_mix_post'] = gain(D_MODEL)
    d['l0_w_in'] = dense(D_MODEL, sum(AB_COLS))
    d['l0_sinks'] = normal((A_HEADS,), 0.5)
    d['l0_mla_q_norm'] = gain(MLA_Q_RANK)
    d['l0_mla_w_uq'] = dense(MLA_Q_RANK, B_HEADS * (MLA_NOPE + MLA_ROPE))
    d['l0_mla_kv_norm'] = gain(MLA_KV_RANK)
    d['l0_mla_w_ukv'] = dense(MLA_KV_RANK, B_HEADS * (MLA_NOPE + MLA_V))
    d['l0_w_out'] = dense(AB_OUT, D_MODEL)
    add_ffn(d, 'l0_ffn2')
    add_ffn(d, 'l1_ffn1')
    d['l1_mix_pre'] = gain(D_MODEL)
    d['l1_mix_post'] = gain(D_MODEL)
    d['l1_w_in'] = dense(D_MODEL, sum(CD_COLS))
    d['l1_nsa_pe_k'] = normal((CMP_BLOCK, HEAD_DIM), 0.3)
    d['l1_nsa_pe_v'] = normal((CMP_BLOCK, HEAD_DIM), 0.3)
    d['l1_nsa_wk1'] = dense(CMP_BLOCK * HEAD_DIM, CMP_HIDDEN)
    d['l1_nsa_wk2'] = dense(CMP_HIDDEN, HEAD_DIM)
    d['l1_nsa_wv1'] = dense(CMP_BLOCK * HEAD_DIM, CMP_HIDDEN)
    d['l1_nsa_wv2'] = dense(CMP_HIDDEN, HEAD_DIM)
    d['l1_w_out'] = dense(CD_OUT, D_MODEL)
    add_ffn(d, 'l1_ffn2')
    return d


def reference(x, rel_bias_table,
              l0_ffn1_pre, l0_ffn1_post, l0_ffn1_wg, l0_ffn1_wu, l0_ffn1_wd,
              l0_mix_pre, l0_mix_post, l0_w_in, l0_sinks, l0_mla_q_norm, l0_mla_w_uq,
              l0_mla_kv_norm, l0_mla_w_ukv, l0_w_out,
              l0_ffn2_pre, l0_ffn2_post, l0_ffn2_wg, l0_ffn2_wu, l0_ffn2_wd,
              l1_ffn1_pre, l1_ffn1_post, l1_ffn1_wg, l1_ffn1_wu, l1_ffn1_wd,
              l1_mix_pre, l1_mix_post, l1_w_in, l1_nsa_pe_k, l1_nsa_pe_v,
              l1_nsa_wk1, l1_nsa_wk2, l1_nsa_wv1, l1_nsa_wv2, l1_w_out,
              l1_ffn2_pre, l1_ffn2_post, l1_ffn2_wg, l1_ffn2_wu, l1_ffn2_wd):
    mixer0 = functools.partial(mixer_swa_mla, w_in=l0_w_in, sinks=l0_sinks, q_norm=l0_mla_q_norm,
                               w_uq=l0_mla_w_uq, kv_norm=l0_mla_kv_norm, w_ukv=l0_mla_w_ukv,
                               w_out=l0_w_out, rel_table=rel_bias_table)
    mixer1 = functools.partial(mixer_nsa_moba, w_in=l1_w_in, pe_k=l1_nsa_pe_k, pe_v=l1_nsa_pe_v,
                               wk1=l1_nsa_wk1, wk2=l1_nsa_wk2, wv1=l1_nsa_wv1, wv2=l1_nsa_wv2,
                               w_out=l1_w_out, rel_table=rel_bias_table)
    layers = (
        ((l0_ffn1_pre, l0_ffn1_post, l0_ffn1_wg, l0_ffn1_wu, l0_ffn1_wd), (l0_mix_pre, l0_mix_post), mixer0,
         (l0_ffn2_pre, l0_ffn2_post, l0_ffn2_wg, l0_ffn2_wu, l0_ffn2_wd)),
        ((l1_ffn1_pre, l1_ffn1_post, l1_ffn1_wg, l1_ffn1_wu, l1_ffn1_wd), (l1_mix_pre, l1_mix_post), mixer1,
         (l1_ffn2_pre, l1_ffn2_post, l1_ffn2_wg, l1_ffn2_wu, l1_ffn2_wd)),
    )
    for layer in range(DEPTH):
        ffn1, mix_norms, mixer, ffn2 = layers[layer]
        x = sandwich(x, ffn1[0], ffn1[1], functools.partial(swiglu, wg=ffn1[2], wu=ffn1[3], wd=ffn1[4]), MACARON_WEIGHT)
        x = sandwich(x, mix_norms[0], mix_norms[1], mixer, 1.0)
        x = sandwich(x, ffn2[0], ffn2[1], functools.partial(swiglu, wg=ffn2[2], wu=ffn2[3], wd=ffn2[4]), MACARON_WEIGHT)
    return x
```

```cpp
#include <hip/hip_runtime.h>
#include <cstdio>
#include <cstdint>

#ifndef ONE_LAUNCH
#define ONE_LAUNCH 0
#endif

#define LAS __attribute__((address_space(3)))
#define GAS __attribute__((address_space(1)))
typedef unsigned short u16;
typedef _Float16 f16;
typedef _Float16 f16x8 __attribute__((ext_vector_type(8)));
typedef _Float16 f16x4 __attribute__((ext_vector_type(4)));
typedef _Float16 f16x2 __attribute__((ext_vector_type(2)));
typedef float f32x4 __attribute__((ext_vector_type(4)));
typedef float f32x2 __attribute__((ext_vector_type(2)));
typedef unsigned u32x4 __attribute__((ext_vector_type(4)));
typedef unsigned u32x2 __attribute__((ext_vector_type(2)));

constexpr int BATCH = 8, SEQ = 2048, DM = 1024, M = BATCH * SEQ, DFF = 2816;
constexpr int NGU = 2 * DFF;
constexpr int N0 = 1280;
constexpr int N1 = 3072;
constexpr float EPS = 1e-6f;
constexpr float LOG2E = 1.4426950408889634f;
constexpr float QS = 0.125f * 1.4426950408889634f;
constexpr float QS96 = (float)(1.4426950408889634 / 9.797958971132712);
constexpr float NEG = -1e30f;
constexpr int Z0_QA = 0, Z0_KA = 512, Z0_VA = 640, Z0_CQ = 768, Z0_CKV = 1024, Z0_KR = 1152;
constexpr int Z1_QC = 0, Z1_KC = 512, Z1_VC = 640, Z1_KS = 768, Z1_VS = 896, Z1_KW = 1024, Z1_VW = 1152, Z1_QD = 1280, Z1_KD = 1792, Z1_VD = 2304, Z1_GL = 2816;
constexpr int NCMP = 127;

constexpr size_t MiB = 1u << 20;
constexpr size_t WS_CTL = 0, CTL_ZERO_BYTES = 1 * MiB;
constexpr size_t WS_BIAS = 1 * MiB;
constexpr size_t WS_ROPE = 1 * MiB + 256 * 1024;
constexpr size_t WS_PEB  = 1 * MiB + 768 * 1024;
constexpr size_t WS_W = 2 * MiB;
constexpr size_t W_GU1 = WS_W, W_D1 = W_GU1 + 11 * MiB, W_GU2 = W_D1 + 5632 * 1024, W_D2 = W_GU2 + 11 * MiB, W_IN = W_D2 + 5632 * 1024;
constexpr size_t W_OUT = W_IN + 6 * MiB, W_UQ = W_OUT + 2 * MiB, W_UKV = W_UQ + 512 * 1024, W_END = W_UKV + 512 * 1024;
constexpr size_t WS_H = 48 * MiB;
constexpr size_t WS_ACT = 80 * MiB;
constexpr size_t WS_Z = WS_ACT;
constexpr size_t WS_CQN = 120 * MiB, WS_CKVN = 128 * MiB, WS_KR = 136 * MiB, WS_QB = 137 * MiB;
constexpr size_t WS_Y = 176 * MiB;
constexpr size_t WS_KVB = WS_Y;
constexpr size_t WS_IMP = WS_Y;
constexpr size_t WS_OCMP = WS_Y + 16 * MiB;
constexpr size_t WS_MISC = 240 * MiB;
constexpr size_t WS_KCMP = WS_MISC, WS_VCMP = WS_MISC + 1 * MiB;
constexpr size_t WS_HID = WS_MISC + 2 * MiB;
constexpr size_t WS_SEL = WS_MISC + 8 * MiB;
constexpr size_t WS_MSEL = WS_MISC + 9 * MiB;
constexpr size_t WS_KMEAN = WS_MISC + 10 * MiB;
constexpr size_t WS_END = 256 * MiB;
static_assert(W_END <= WS_H && WS_QB + (size_t)M * 768 * 2 <= WS_Y && WS_OCMP + (size_t)M * 512 * 4 <= WS_MISC, "ws map");

constexpr int NWAVES = 8, NTHREADS = 512;
constexpr int LDS_BYTES = 147456;
constexpr int RING_BYTES = 131072;
constexpr int MISC_OFF = RING_BYTES + 320;

namespace pg8 {
constexpr int BM = 256, BK = 64, HALF = 128, HTB = HALF * BK * 2, STAGE_BYTES = 8 * HTB, NXCD = 8, WGM = 8;
__host__ __device__ __forceinline__ int lds_byte(int r, int c) { const int st = (r >> 4) * 2 + (c >> 5), rr = r & 15, cc = c & 31, ob = rr * 64 + cc * 2; return st * 1024 + (ob ^ (((ob >> 9) & 1) << 5)); }
__host__ __device__ __forceinline__ void stage_rc(int b, int& R, int& C) { const int st = b / 1024, sb = b % 1024, swz = sb ^ (((sb >> 9) & 1) << 5); R = (st >> 1) * 16 + swz / 64; C = (st & 1) * 32 + (swz % 64) / 2; }
__host__ __device__ __forceinline__ int perm32(int rho) { const int n = rho >> 4, i = rho & 15; return 8 * (i >> 2) + 4 * n + (i & 3); }

struct Unit { int pm, pn; };
struct Gemm { const u16* A; const u16* Bt; int M, N, K, lda; };

struct StaticOrder {
    int nM, nN, nwg, G, c;
    __host__ __device__ void init(int M_, int N_, int G_, int c_) { nM = M_ / BM; nN = N_ / BM; nwg = nM * nN; G = G_; c = c_; }
    __host__ __device__ bool next(int i, Unit& u) const {
        const long L = (long)i * G + c; if (L >= nwg) return false;
        int wgid = (int)L; { const int q = nwg / NXCD, r = nwg % NXCD, xcd = wgid % NXCD, off = wgid / NXCD; wgid = (xcd < r ? xcd * (q + 1) : r * (q + 1) + (xcd - r) * q) + off; }
        const int nig = WGM * nN, gid = wgid / nig, fm = gid * WGM, gsz = (nM - fm) < WGM ? (nM - fm) : WGM;
        u.pm = fm + ((wgid % nig) % gsz); u.pn = (wgid % nig) / gsz; return true;
    }
    __device__ __forceinline__ void a_ready(const Unit&) const {}
    __device__ __forceinline__ void done(const Unit&) const {}
};

__device__ __forceinline__ unsigned pk_f16(float lo, float hi) { f16x2 v = {(f16)lo, (f16)hi}; return __builtin_bit_cast(unsigned, v); }

struct EpiF16 {
    static constexpr bool PERM = true;
    u16* O; int ldc;
    __device__ __forceinline__ void operator()(const f32x4 (&acc)[2][2][4][2], const Unit& u, int wr, int wc, int fr, int fq) const {
        const int row0 = u.pm * BM + wr * 64 + fr, col0 = u.pn * BM + wc * 32 + 8 * fq;
#pragma unroll
        for (int ai = 0; ai < 2; ++ai)
#pragma unroll
            for (int m = 0; m < 4; ++m) { u16* rowp = O + (size_t)(row0 + ai * HALF + m * 16) * ldc + col0;
#pragma unroll
                for (int bj = 0; bj < 2; ++bj) { const f32x4 v0 = acc[ai][bj][m][0], v1 = acc[ai][bj][m][1];
                    u32x4 w; w.x = pk_f16(v0[0], v0[1]); w.y = pk_f16(v0[2], v0[3]); w.z = pk_f16(v1[0], v1[1]); w.w = pk_f16(v1[2], v1[3]);
                    *(u32x4*)(rowp + bj * HALF) = w; } }
    }
};
__device__ __forceinline__ float silu_mul(float g, float u) { return g * u * __builtin_amdgcn_rcpf(1.0f + __builtin_amdgcn_exp2f(-g * LOG2E)); }
struct EpiSwiglu {
    static constexpr bool PERM = true;
    u16* O; int ldc;
    __device__ __forceinline__ void operator()(const f32x4 (&acc)[2][2][4][2], const Unit& u, int wr, int wc, int fr, int fq) const {
        const int row0 = u.pm * BM + wr * 64 + fr, col0 = u.pn * HALF + wc * 32 + 8 * fq;
#pragma unroll
        for (int ai = 0; ai < 2; ++ai)
#pragma unroll
            for (int m = 0; m < 4; ++m) { u16* rowp = O + (size_t)(row0 + ai * HALF + m * 16) * ldc + col0;
                const f32x4 g0 = acc[ai][0][m][0], g1 = acc[ai][0][m][1], u0 = acc[ai][1][m][0], u1 = acc[ai][1][m][1];
                u32x4 w; w.x = pk_f16(silu_mul(g0[0], u0[0]), silu_mul(g0[1], u0[1])); w.y = pk_f16(silu_mul(g0[2], u0[2]), silu_mul(g0[3], u0[3]));
                w.z = pk_f16(silu_mul(g1[0], u1[0]), silu_mul(g1[1], u1[1])); w.w = pk_f16(silu_mul(g1[2], u1[2]), silu_mul(g1[3], u1[3]));
                *(u32x4*)rowp = w; }
    }
};
struct EpiF32 {
    static constexpr bool PERM = false;
    float* C; int ldc;
    __device__ __forceinline__ void operator()(const f32x4 (&acc)[2][2][4][2], const Unit& u, int wr, int wc, int fr, int fq) const {
        const int row0 = u.pm * BM + wr * 64 + fr, col0 = u.pn * BM + wc * 32 + 4 * fq;
#pragma unroll
        for (int ai = 0; ai < 2; ++ai)
#pragma unroll
            for (int m = 0; m < 4; ++m) { float* rowp = C + (size_t)(row0 + ai * HALF + m * 16) * ldc + col0;
#pragma unroll
                for (int bj = 0; bj < 2; ++bj)
#pragma unroll
                    for (int n = 0; n < 2; ++n) *(f32x4*)(rowp + bj * HALF + n * 16) = acc[ai][bj][m][n]; }
    }
};

template <class Epi, class Sched, bool ALIGN_EPI>
__device__ __forceinline__ void gemm_phase(LAS unsigned char* lds, const Gemm g, const Sched& S, const Epi& E) {
    const int tid = threadIdx.x, wid = __builtin_amdgcn_readfirstlane(tid >> 6), lane = tid & 63, wr = wid >> 2, wc = wid & 3, fr = lane & 15, fq = lane >> 4;
    const int K = g.K, nt = K / BK, lda = g.lda;
    unsigned voffA[2], voffB[2];
#pragma unroll
    for (int i = 0; i < 2; ++i) { int R, C; stage_rc(tid * 16 + i * 8192, R, C); const int Rb = Epi::PERM ? ((R & ~31) + perm32(R & 31)) : R;
        voffA[i] = (unsigned)(R * lda + C) * 2u; voffB[i] = (unsigned)(Rb * K + C) * 2u; }
    const size_t kstep = (size_t)(BK * 2);
    const size_t hstepA = (size_t)HALF * lda * 2, hstepB = (size_t)HALF * K * 2;
    const size_t tstepA = 2 * hstepA, tstepB = 2 * hstepB;
    const unsigned ldsw = (unsigned)wid * 1024u;
    const int aoff = lds_byte(wr * 64 + fr, fq * 8), boff = lds_byte(wc * 32 + fr, fq * 8);
#define PG8_SA(b, h) (((b) * 2 + (h)) * HTB)
#define PG8_SB(b, h) ((4 + (b) * 2 + (h)) * HTB)
#define PG8_STAGE(bufoff, gbase, voff) do { _Pragma("unroll") for (int _i = 0; _i < 2; ++_i) \
        __builtin_amdgcn_global_load_lds((const unsigned*)((const char*)(gbase) + (voff)[_i]), (LAS unsigned*)(lds + (bufoff) + ldsw + _i * 8192), 16, 0, 0); } while (0)
#define PG8_LDA(dst, b, h) do { _Pragma("unroll") for (int m = 0; m < 4; ++m) _Pragma("unroll") for (int k = 0; k < 2; ++k) dst[m][k] = *(const LAS f16x8*)(lds + PG8_SA(b, h) + aoff + m * 2048 + k * 1024); } while (0)
#define PG8_LDB(dst, b, h) do { _Pragma("unroll") for (int n = 0; n < 2; ++n) _Pragma("unroll") for (int k = 0; k < 2; ++k) dst[n][k] = *(const LAS f16x8*)(lds + PG8_SB(b, h) + boff + n * 2048 + k * 1024); } while (0)
#define PG8_MMA(ai, bj, At, Bt) do { __builtin_amdgcn_s_setprio(1); _Pragma("unroll") for (int m = 0; m < 4; ++m) _Pragma("unroll") for (int n = 0; n < 2; ++n) _Pragma("unroll") for (int k = 0; k < 2; ++k) \
        acc[ai][bj][m][n] = __builtin_amdgcn_mfma_f32_16x16x32_f16(Bt[n][k], At[m][k], acc[ai][bj][m][n], 0, 0, 0); __builtin_amdgcn_s_setprio(0); } while (0)
#define PG8_WAIT_V(n) asm volatile("s_waitcnt vmcnt(" #n ")" ::: "memory")
#define PG8_WAIT_L(n) asm volatile("s_waitcnt lgkmcnt(" #n ")" ::: "memory")
#define PG8_BAR __builtin_amdgcn_s_barrier()
#define PG8_SCHED __builtin_amdgcn_sched_barrier(0)
    Unit cur, nxt; int ui = 0;
    if (!S.next(0, cur)) return;
    f32x4 acc[2][2][4][2];
#pragma unroll
    for (int a = 0; a < 2; ++a)
#pragma unroll
        for (int b = 0; b < 2; ++b)
#pragma unroll
            for (int m = 0; m < 4; ++m)
#pragma unroll
                for (int n = 0; n < 2; ++n) acc[a][b][m][n] = (f32x4){0.f, 0.f, 0.f, 0.f};
    f16x8 At[4][2], B0[2][2], B1[2][2];
    const char* cA = (const char*)g.A + (size_t)cur.pm * tstepA; const char* cB = (const char*)g.Bt + (size_t)cur.pn * tstepB;
    S.a_ready(cur);
    PG8_STAGE(PG8_SB(0, 0), cB, voffB); PG8_STAGE(PG8_SB(0, 1), cB + hstepB, voffB); PG8_STAGE(PG8_SA(0, 0), cA, voffA); PG8_STAGE(PG8_SA(0, 1), cA + hstepA, voffA);
    if (wr == 1) PG8_BAR;
    PG8_WAIT_V(2); PG8_BAR;
    PG8_STAGE(PG8_SB(1, 0), cB + kstep, voffB); PG8_STAGE(PG8_SA(1, 0), cA + kstep, voffA); PG8_STAGE(PG8_SB(1, 1), cB + hstepB + kstep, voffB);
    PG8_WAIT_V(6); PG8_BAR;
    for (;;) {
        const bool has_next = S.next(ui + 1, nxt);
        const char* nA = has_next ? (const char*)g.A + (size_t)nxt.pm * tstepA : cA; const char* nB = has_next ? (const char*)g.Bt + (size_t)nxt.pn * tstepB : cB;
        for (int t = 0; t < nt; t += 2) {
            const bool last = (t == nt - 2);
            const char* a1 = cA + (size_t)(t + 1) * kstep;
            const char* a2 = last ? nA : cA + (size_t)(t + 2) * kstep; const char* b2 = last ? nB : cB + (size_t)(t + 2) * kstep;
            const char* a3 = a2 + kstep; const char* b3 = b2 + kstep;
            if (last && has_next) S.a_ready(nxt);
            PG8_LDB(B0, 0, 0); PG8_LDB(B1, 0, 1); PG8_SCHED; PG8_LDA(At, 0, 0); PG8_STAGE(PG8_SA(1, 1), a1 + hstepA, voffA);
            PG8_WAIT_V(8); PG8_WAIT_L(0); PG8_BAR; PG8_MMA(0, 0, At, B0); PG8_MMA(0, 1, At, B1); PG8_BAR; PG8_SCHED;
            PG8_LDA(At, 0, 1); PG8_STAGE(PG8_SB(0, 0), b2, voffB); PG8_STAGE(PG8_SB(0, 1), b2 + hstepB, voffB); PG8_STAGE(PG8_SA(0, 0), a2, voffA);
            PG8_WAIT_V(8); PG8_WAIT_L(0); PG8_BAR; PG8_MMA(1, 0, At, B0); PG8_MMA(1, 1, At, B1); PG8_BAR; PG8_SCHED;
            PG8_LDB(B0, 1, 0); PG8_LDB(B1, 1, 1); PG8_SCHED; PG8_LDA(At, 1, 0); PG8_STAGE(PG8_SA(0, 1), a2 + hstepA, voffA);
            PG8_WAIT_V(8); PG8_WAIT_L(0); PG8_BAR; PG8_MMA(0, 0, At, B0); PG8_MMA(0, 1, At, B1); PG8_BAR; PG8_SCHED;
            PG8_LDA(At, 1, 1); PG8_STAGE(PG8_SB(1, 0), b3, voffB); PG8_STAGE(PG8_SB(1, 1), b3 + hstepB, voffB); PG8_STAGE(PG8_SA(1, 0), a3, voffA);
            PG8_WAIT_V(8); PG8_WAIT_L(0); PG8_BAR; PG8_MMA(1, 0, At, B0); PG8_MMA(1, 1, At, B1); PG8_BAR; PG8_SCHED;
        }
        if constexpr (ALIGN_EPI) { if (wr == 0) PG8_BAR; }
        E(acc, cur, wr, wc, fr, fq); S.done(cur);
        if (!has_next) break;
#pragma unroll
        for (int a = 0; a < 2; ++a)
#pragma unroll
            for (int b = 0; b < 2; ++b)
#pragma unroll
                for (int m = 0; m < 4; ++m)
#pragma unroll
                    for (int n = 0; n < 2; ++n) acc[a][b][m][n] = (f32x4){0.f, 0.f, 0.f, 0.f};
        cur = nxt; cA = nA; cB = nB; ++ui;
        if constexpr (ALIGN_EPI) { if (wr == 1) PG8_BAR; }
    }
    PG8_WAIT_V(0);
    if constexpr (!ALIGN_EPI) { if (wr == 0) PG8_BAR; }
    PG8_BAR;
#undef PG8_SA
#undef PG8_SB
#undef PG8_STAGE
#undef PG8_LDA
#undef PG8_LDB
#undef PG8_MMA
#undef PG8_WAIT_V
#undef PG8_WAIT_L
#undef PG8_BAR
#undef PG8_SCHED
}
}

#define XB_TMO      128
#define XB_XCNT(j)  (256  + 64 * (j))
#define XB_XSUB(j)  (1280 + 64 * (j))
#define XB_XGEN(j)  (2304 + 64 * (j))
#define XB_TOP      3328
#define XB_TOPGEN   3392
#define XCD_BAR_WORDS 3456
#define XB_SPIN_CAP (1u << 23)
__device__ __forceinline__ unsigned xb_ld(unsigned* p)              { return __hip_atomic_load(p, __ATOMIC_RELAXED, __HIP_MEMORY_SCOPE_AGENT); }
__device__ __forceinline__ unsigned xb_add(unsigned* p, unsigned v) { return __hip_atomic_fetch_add(p, v, __ATOMIC_RELAXED, __HIP_MEMORY_SCOPE_AGENT); }
__device__ __forceinline__ unsigned xb_xcc_id() { return (unsigned)__builtin_amdgcn_s_getreg((3 << 11) | 20) & 0xFu; }
#define XB_SPIN(cond, bar) do { unsigned _sp = 0; while (cond) { __builtin_amdgcn_s_sleep(1); \
    if ((++_sp & 255u) == 0u) { if (xb_ld(&(bar)[XB_TMO])) break; if (_sp > XB_SPIN_CAP) { atomicAdd(&(bar)[XB_TMO], 1u); break; } } } } while (0)
struct XcdBarrier { unsigned* bar; unsigned x; volatile LAS unsigned* st; };
__device__ __forceinline__ XcdBarrier xcd_barrier_post(unsigned* bar, volatile LAS unsigned* st) {
    XcdBarrier b; b.bar = bar; b.x = xb_xcc_id(); b.st = st;
    if (threadIdx.x == 0) (void)xb_add(&bar[XB_XCNT(b.x)], 1u);
    return b;
}
__device__ __forceinline__ void xcd_barrier_complete(unsigned* bar, unsigned x, unsigned& nloc, unsigned& nx) {
    const unsigned G = gridDim.x * gridDim.y * gridDim.z;
    unsigned sum, cnt, mine, sp = 0u;
    for (;;) {
        sum = 0u; cnt = 0u; mine = 0u;
#pragma unroll
        for (unsigned j = 0; j < 16; ++j) { const unsigned c = xb_ld(&bar[XB_XCNT(j)]); sum += c; cnt += (c > 0u) ? 1u : 0u; mine = (j == x) ? c : mine; }
        if (sum == G) break;
        __builtin_amdgcn_s_sleep(1);
        if ((++sp & 255u) == 0u) { if (xb_ld(&bar[XB_TMO])) break; if (sp > XB_SPIN_CAP) { atomicAdd(&bar[XB_TMO], 1u); break; } }
    }
    nloc = mine > 0u ? mine : 1u; nx = cnt > 0u ? cnt : 1u;
}
__device__ __forceinline__ void xcd_barrier(const XcdBarrier& b) {
    asm volatile("s_waitcnt vmcnt(0)" ::: "memory");
    __syncthreads();
    if (threadIdx.x == 0) {
        unsigned* bar = b.bar;
        __builtin_amdgcn_s_waitcnt(0);
        unsigned nloc = b.st[0], nx = b.st[1];
        if (nloc == 0u) { xcd_barrier_complete(bar, b.x, nloc, nx); b.st[0] = nloc; b.st[1] = nx; }
        const unsigned old = xb_add(&bar[XB_XSUB(b.x)], 1u);
        const unsigned gen = old / nloc;
        if (old + 1u == (gen + 1u) * nloc) {
            __builtin_amdgcn_fence(__ATOMIC_RELEASE, "agent");
            asm volatile("s_waitcnt vmcnt(0)" ::: "memory");
            const unsigned og = xb_add(&bar[XB_TOP], 1u);
            const unsigned tg = og / nx;
            if (og + 1u == (tg + 1u) * nx) xb_add(&bar[XB_TOPGEN], 1u);
            else XB_SPIN(xb_ld(&bar[XB_TOPGEN]) == tg, bar);
            __builtin_amdgcn_fence(__ATOMIC_ACQUIRE, "agent");
            xb_add(&bar[XB_XGEN(b.x)], 1u);
            asm volatile("s_waitcnt vmcnt(0)" ::: "memory");
        } else {
            XB_SPIN(xb_ld(&bar[XB_XGEN(b.x)]) == gen, bar);
            __builtin_amdgcn_fence(__ATOMIC_ACQUIRE, "agent");
            asm volatile("s_waitcnt vmcnt(0)" ::: "memory");
        }
    }
    __syncthreads();
}

__device__ __forceinline__ float wave_sum(float v) {
#pragma unroll
    for (int o = 1; o < 64; o <<= 1) v += __shfl_xor(v, o);
    return v;
}
__device__ __forceinline__ int t5_bucket(int n) {
    if (n < 16) return n;
    int b = 16;
    b += (n >= 21); b += (n >= 27); b += (n >= 35); b += (n >= 46); b += (n >= 59); b += (n >= 77); b += (n >= 99); b += (n >= 128);
    b += (n >= 166); b += (n >= 216); b += (n >= 280); b += (n >= 363); b += (n >= 470); b += (n >= 609); b += (n >= 790);
    return b;
}

__device__ __forceinline__ int conv_row(int mode, int n) {
    if (mode == 1) return 256 * (n >> 7) + (n & 127);
    if (mode == 2) return 256 * (n >> 7) + 128 + (n & 127);
    if (mode == 4) return n < 1280 ? n : (n < 1304 ? 2816 + (n - 1280) : n - 24);
    return n;
}
__device__ __forceinline__ float conv_scale(int mode, int n) {
    if (mode == 3) return n < 512 ? QS : 1.0f;
    if (mode == 4) return (n < 512 || (n >= 1304 && n < 1816)) ? QS : 1.0f;
    if (mode == 5) return QS96;
    return 1.0f;
}
__device__ __forceinline__ void conv_matrix(const float* W, int K, int N, u16* WT, int ldk, int mode, LAS float* scr, int gw, int NGW, int lane) {
    const int nblk = (N + 31) / 32, nitems = (K / 64) * nblk;
    for (int item = gw; item < nitems; item += NGW) {
        const int kb = item / nblk, nb = item % nblk, k0 = 64 * kb, n0 = 32 * nb;
        const int nl = n0 + (lane & 31);
#pragma unroll 8
        for (int i = 0; i < 32; ++i) { const int kk = 2 * i + (lane >> 5); scr[kk * 33 + (lane & 31)] = (nl < N) ? W[(size_t)(k0 + kk) * N + nl] : 0.f; }
        asm volatile("s_waitcnt lgkmcnt(0)" ::: "memory");
        const int c = lane & 7;
#pragma unroll
        for (int j = 0; j < 4; ++j) { const int n = (lane >> 3) + 8 * j; const LAS float* s = scr + (8 * c) * 33 + n;
            if (n0 + n < N) { const float sc = conv_scale(mode, n0 + n);
                u32x4 o; o.x = pg8::pk_f16(s[0 * 33] * sc, s[1 * 33] * sc); o.y = pg8::pk_f16(s[2 * 33] * sc, s[3 * 33] * sc); o.z = pg8::pk_f16(s[4 * 33] * sc, s[5 * 33] * sc); o.w = pg8::pk_f16(s[6 * 33] * sc, s[7 * 33] * sc);
                *(u32x4*)(WT + (size_t)conv_row(mode, n0 + n) * ldk + k0 + 8 * c) = o; } }
        asm volatile("s_waitcnt lgkmcnt(0)" ::: "memory");
    }
}
__device__ __forceinline__ void zero_u32x4(void* p, size_t n16, int gtid, int NT) { for (size_t i = gtid; i < n16; i += NT) ((u32x4*)p)[i] = (u32x4){0u, 0u, 0u, 0u}; }

template <bool HASY, bool HASH>
__device__ __forceinline__ void norm_rows(const float* Xin, const float* Y, const float* post, float w, float* Xout, const float* pre, u16* H, int gw, int NGW, int lane) {
    for (int m = gw; m < M; m += NGW) {
        const f32x4* xr = (const f32x4*)(Xin + (size_t)m * DM) + lane;
        f32x4 x[4];
#pragma unroll
        for (int j = 0; j < 4; ++j) x[j] = xr[64 * j];
        if (HASY) {
            const f32x4* yr = (const f32x4*)(Y + (size_t)m * DM) + lane; f32x4 y[4]; float ss = 0.f;
#pragma unroll
            for (int j = 0; j < 4; ++j) { y[j] = yr[64 * j]; ss += (y[j].x * y[j].x + y[j].y * y[j].y) + (y[j].z * y[j].z + y[j].w * y[j].w); }
            const float rstd = 1.0f / sqrtf(wave_sum(ss) * (1.0f / DM) + EPS) * w;
#pragma unroll
            for (int j = 0; j < 4; ++j) { const f32x4 pg = ((const f32x4*)post)[lane + 64 * j]; x[j] = x[j] + y[j] * rstd * pg; }
        }
        f32x4* xo = (f32x4*)(Xout + (size_t)m * DM) + lane;
#pragma unroll
        for (int j = 0; j < 4; ++j) xo[64 * j] = x[j];
        if (HASH) {
            float ss = 0.f;
#pragma unroll
            for (int j = 0; j < 4; ++j) ss += (x[j].x * x[j].x + x[j].y * x[j].y) + (x[j].z * x[j].z + x[j].w * x[j].w);
            const float rstd = 1.0f / sqrtf(wave_sum(ss) * (1.0f / DM) + EPS);
            u32x2* ho = (u32x2*)(H + (size_t)m * DM) + lane;
#pragma unroll
            for (int j = 0; j < 4; ++j) { const f32x4 pg = ((const f32x4*)pre)[lane + 64 * j]; const f32x4 h = x[j] * rstd * pg;
                u32x2 o; o.x = pg8::pk_f16(h.x, h.y); o.y = pg8::pk_f16(h.z, h.w); ho[64 * j] = o; }
        }
    }
}

__device__ __forceinline__ void mla_prep(const u16* Z0, const float* qn, const float* kvn, const f32x2* rope, u16* CQN, u16* CKVN, u16* KRb, int gw, int NGW, int lane) {
    for (int m = gw; m < M; m += NGW) {
        const f16* z = (const f16*)Z0 + (size_t)m * N0;
        { const f16x4 c = *(const f16x4*)(z + Z0_CQ + 4 * lane); const float c0 = (float)c[0], c1 = (float)c[1], c2 = (float)c[2], c3 = (float)c[3];
          const float rstd = 1.0f / sqrtf(wave_sum((c0 * c0 + c1 * c1) + (c2 * c2 + c3 * c3)) * (1.0f / 256.f) + EPS);
          const f32x4 g = ((const f32x4*)qn)[lane];
          u32x2 o; o.x = pg8::pk_f16(c0 * rstd * g.x, c1 * rstd * g.y); o.y = pg8::pk_f16(c2 * rstd * g.z, c3 * rstd * g.w);
          *((u32x2*)(CQN + (size_t)m * 256) + lane) = o; }
        { const f16x2 c = *(const f16x2*)(z + Z0_CKV + 2 * lane); const float c0 = (float)c[0], c1 = (float)c[1];
          const float rstd = 1.0f / sqrtf(wave_sum(c0 * c0 + c1 * c1) * (1.0f / 128.f) + EPS);
          const f32x2 g = ((const f32x2*)kvn)[lane];
          unsigned* o = (unsigned*)(CKVN + (size_t)m * 256);
          o[lane] = pg8::pk_f16(c0 * rstd * g.x, c1 * rstd * g.y); o[64 + lane] = 0u; }
        if (lane < 16) { const float x1 = (float)z[Z0_KR + lane], x2 = (float)z[Z0_KR + 16 + lane]; const f32x2 cs = rope[(m & (SEQ - 1)) * 16 + lane];
          f16* o = (f16*)KRb + (size_t)m * 32; o[lane] = (f16)(x1 * cs.x - x2 * cs.y); o[16 + lane] = (f16)(x2 * cs.x + x1 * cs.y); }
    }
}

template <int DQK, class KeyFn, class ScoreFn>
__device__ __forceinline__ void naive_attend(const float (&q)[DQK], float& m, float& l, float (&o)[64], int klo, int khi, const KeyFn& kf, const ScoreFn& sf) {
    for (int kp = klo; kp <= khi; ++kp) {
        const f16x8* kr = (const f16x8*)kf.k(kp);
        float s = 0.f;
#pragma unroll
        for (int c = 0; c < 8; ++c) { const f16x8 kv = kr[c];
#pragma unroll
            for (int j = 0; j < 8; ++j) s += q[c * 8 + j] * (float)kv[j]; }
        if constexpr (DQK == 96) { const f16x8* k2 = (const f16x8*)kf.k2(kp);
#pragma unroll
            for (int c = 0; c < 4; ++c) { const f16x8 kv = k2[c];
#pragma unroll
                for (int j = 0; j < 8; ++j) s += q[64 + c * 8 + j] * (float)kv[j]; } }
        if (sf(kp, s)) {
            const float mn = fmaxf(m, s), a = __builtin_amdgcn_exp2f(m - mn), p = __builtin_amdgcn_exp2f(s - mn);
            m = mn; l = l * a + p;
            const f16x8* vr = (const f16x8*)kf.v(kp);
#pragma unroll
            for (int c = 0; c < 8; ++c) { const f16x8 vv = vr[c];
#pragma unroll
                for (int j = 0; j < 8; ++j) o[c * 8 + j] = o[c * 8 + j] * a + p * (float)vv[j]; }
        }
    }
}
struct KeyZ { const f16* kbase; const f16* vbase; int pitch;
    __device__ __forceinline__ const f16* k(int kp) const { return kbase + (size_t)kp * pitch; }
    __device__ __forceinline__ const f16* k2(int) const { return nullptr; }
    __device__ __forceinline__ const f16* v(int kp) const { return vbase + (size_t)kp * pitch; } };
struct KeyMLA { const f16* kvb; const f16* kr;
    __device__ __forceinline__ const f16* k(int kp) const { return kvb + (size_t)kp * 1024; }
    __device__ __forceinline__ const f16* k2(int kp) const { return kr + (size_t)kp * 32; }
    __device__ __forceinline__ const f16* v(int kp) const { return kvb + (size_t)kp * 1024 + 64; } };

__device__ __forceinline__ void store_o64(u16* dst, const float (&o)[64], float sc) {
#pragma unroll
    for (int c = 0; c < 8; ++c) { u32x4 w; w.x = pg8::pk_f16(o[c * 8 + 0] * sc, o[c * 8 + 1] * sc); w.y = pg8::pk_f16(o[c * 8 + 2] * sc, o[c * 8 + 3] * sc);
        w.z = pg8::pk_f16(o[c * 8 + 4] * sc, o[c * 8 + 5] * sc); w.w = pg8::pk_f16(o[c * 8 + 6] * sc, o[c * 8 + 7] * sc); ((u32x4*)dst)[c] = w; }
}
template <int N> __device__ __forceinline__ void load_q(float (&q)[N], const f16* src, int off, int cnt8) {
#pragma unroll
    for (int c = 0; c < cnt8; ++c) { const f16x8 v = ((const f16x8*)src)[c];
#pragma unroll
        for (int j = 0; j < 8; ++j) q[off + c * 8 + j] = (float)v[j]; }
}

__device__ __forceinline__ void l0_attn_naive(const u16* Z0, const u16* QBp, const u16* KVBp, const u16* KRp, const float* bias, const f32x2* rope, const float* sinks, u16* O, int wave, int lane) {
    for (int tb = blockIdx.x; tb < M / 64; tb += gridDim.x) {
        const int token = tb * 64 + lane, b = token / SEQ, qpos = token % SEQ, qmin = (tb * 64) % SEQ, head = wave, hkv = head >> 2;
        {
            float q[64], o[64];
            load_q<64>(q, (const f16*)Z0 + (size_t)token * N0 + Z0_QA + head * 64, 0, 8);
#pragma unroll
            for (int d = 0; d < 64; ++d) o[d] = 0.f;
            float m = sinks[head] * LOG2E, l = 1.f;
            const KeyZ kf{(const f16*)Z0 + (size_t)b * SEQ * N0 + Z0_KA + hkv * 64, (const f16*)Z0 + (size_t)b * SEQ * N0 + Z0_VA + hkv * 64, N0};
            const float* bt = bias + (0 + head) * 2048;
            auto sf = [&](int kp, float& s) -> bool { const int d = qpos - kp; if (d < 0 || d >= 128) return false; s += bt[d]; return true; };
            const int klo = qmin - 127 < 0 ? 0 : qmin - 127;
            naive_attend<64>(q, m, l, o, klo, qmin + 63, kf, sf);
            store_o64(O + (size_t)token * DM + head * 64, o, 1.0f / l);
        }
        {
            float q[96], o[64];
            load_q<96>(q, (const f16*)QBp + (size_t)token * 768 + head * 96, 0, 12);
#pragma unroll
            for (int i = 0; i < 16; ++i) { const f32x2 cs = rope[qpos * 16 + i]; const float x1 = q[64 + i], x2 = q[80 + i]; q[64 + i] = x1 * cs.x - x2 * cs.y; q[80 + i] = x2 * cs.x + x1 * cs.y; }
#pragma unroll
            for (int d = 0; d < 64; ++d) o[d] = 0.f;
            float m = NEG, l = 0.f;
            const KeyMLA kf{(const f16*)KVBp + (size_t)b * SEQ * 1024 + head * 128, (const f16*)KRp + (size_t)b * SEQ * 32};
            auto sf = [&](int kp, float&) -> bool { return kp <= qpos; };
            naive_attend<96>(q, m, l, o, 0, qmin + 63, kf, sf);
            store_o64(O + (size_t)token * DM + 512 + head * 64, o, 1.0f / l);
        }
    }
}

__device__ __forceinline__ void l1_compress_hidden(const u16* Z1, const float* pe_k, const float* pe_v, const float* wk1, const float* wv1, float* HID, float* KMEAN, int gw, int NGW, int lane) {
    const int nitems = 2 * BATCH * NCMP * 2 * 4;
    for (int it = gw; it < nitems; it += NGW) {
        const int nb = it & 3, row = (it >> 2) % (BATCH * NCMP * 2), sel = (it >> 2) / (BATCH * NCMP * 2);
        const int hkv = row & 1, c = (row >> 1) % NCMP, b = (row >> 1) / NCMP, n = nb * 64 + lane;
        const f16* x = (const f16*)Z1 + ((size_t)b * SEQ + 16 * c) * N1 + (sel ? Z1_VC : Z1_KC) + hkv * 64;
        const float* pe = sel ? pe_v : pe_k; const float* w1 = sel ? wv1 : wk1;
        float acc = 0.f;
        for (int i = 0; i < 32; ++i) {
            const f16* xr = x + (size_t)i * N1;
#pragma unroll 8
            for (int d = 0; d < 64; ++d) acc += ((float)xr[d] + pe[i * 64 + d]) * w1[(size_t)(i * 64 + d) * 256 + n];
        }
        HID[((size_t)sel * (BATCH * NCMP * 2) + row) * 256 + n] = acc / (1.0f + __expf(-acc));
    }
    for (int it = gw; it < BATCH * 8 * 8; it += NGW) {
        const int h = it & 7, nbk = (it >> 3) & 7, b = it >> 6;
        const f16* x = (const f16*)Z1 + ((size_t)b * SEQ + nbk * 256) * N1 + Z1_KD + h * 64 + lane;
        float s = 0.f;
        for (int t = 0; t < 256; ++t) s += (float)x[(size_t)t * N1];
        KMEAN[(size_t)it * 64 + lane] = s * (1.0f / 256.f);
    }
}
__device__ __forceinline__ void l1_compress_out(const float* HID, const float* wk2, const float* wv2, float* KCMP, float* VCMP, int gw, int NGW, int lane) {
    const int nrows = BATCH * NCMP * 2;
    for (int it = gw; it < 2 * nrows; it += NGW) {
        const int sel = it / nrows, row = it % nrows;
        const float* h = HID + ((size_t)sel * nrows + row) * 256; const float* w2 = sel ? wv2 : wk2;
        float acc = 0.f;
        for (int n = 0; n < 256; ++n) acc += h[n] * w2[n * 64 + lane];
        (sel ? VCMP : KCMP)[(size_t)row * 64 + lane] = acc;
    }
}
__device__ __forceinline__ void l1_cmp_attn(const u16* Z1, const float* KCMP, const float* VCMP, float* OCMP, float* IMP, int wave, int lane) {
    for (int tb = blockIdx.x; tb < M / 64; tb += gridDim.x) {
        const int token = tb * 64 + lane, b = token / SEQ, qpos = token % SEQ, qmin = (tb * 64) % SEQ, head = wave, hkv = head >> 2;
        float q[64], o[64];
        load_q<64>(q, (const f16*)Z1 + (size_t)token * N1 + Z1_QC + head * 64, 0, 8);
#pragma unroll
        for (int d = 0; d < 64; ++d) o[d] = 0.f;
        const int cmax = qpos >= 31 ? (qpos - 31) >> 4 : -1;
        const int cmaxw = (qmin + 63 - 31) >> 4;
        const float* kc = KCMP + ((size_t)b * NCMP * 2 + hkv) * 64; const float* vc = VCMP + ((size_t)b * NCMP * 2 + hkv) * 64;
        float m = NEG, l = 0.f;
        for (int c = 0; c <= cmaxw && c < NCMP; ++c) {
            const float* kr = kc + (size_t)c * 128; float s = 0.f;
#pragma unroll
            for (int d = 0; d < 64; ++d) s += q[d] * kr[d];
            if (c <= cmax) { const float mn = fmaxf(m, s), a = __builtin_amdgcn_exp2f(m - mn), p = __builtin_amdgcn_exp2f(s - mn); m = mn; l = l * a + p;
                const float* vr = vc + (size_t)c * 128;
#pragma unroll
                for (int d = 0; d < 64; ++d) o[d] = o[d] * a + p * vr[d]; }
        }
        const float inv = l > 0.f ? 1.0f / l : 0.f;
        float* op = OCMP + (size_t)token * 512 + head * 64;
#pragma unroll
        for (int d = 0; d < 64; d += 4) *(f32x4*)(op + d) = (f32x4){o[d] * inv, o[d + 1] * inv, o[d + 2] * inv, o[d + 3] * inv};
        float* ip = IMP + ((size_t)token * 8 + head) * 32;
        for (int j = 0; j < 32; ++j) {
            float acc = 0.f;
            if (4 * j - 1 <= cmaxw) {
#pragma unroll
                for (int cc = -1; cc < 4; ++cc) { const int c = 4 * j + cc;
                    if (c >= 0 && c < NCMP && c <= cmaxw) { const float* kr = kc + (size_t)c * 128; float s = 0.f;
#pragma unroll
                        for (int d = 0; d < 64; ++d) s += q[d] * kr[d];
                        if (c <= cmax) acc += __builtin_amdgcn_exp2f(s - m) * inv; } }
            }
            ip[j] = acc;
        }
    }
}
__device__ __forceinline__ void l1_select(const u16* Z1, const float* IMP, const float* KMEAN, unsigned* SEL, unsigned* MSEL, int gtid, int NT) {
    for (int r = gtid; r < M * 2; r += NT) {
        const int token = r >> 1, hkv = r & 1, qpos = token % SEQ, cur = qpos >> 6;
        float v[32];
#pragma unroll
        for (int j = 0; j < 32; ++j) v[j] = 0.f;
#pragma unroll
        for (int g = 0; g < 4; ++g) { const f32x4* ip = (const f32x4*)(IMP + ((size_t)token * 8 + hkv * 4 + g) * 32);
#pragma unroll
            for (int j4 = 0; j4 < 8; ++j4) { const f32x4 t = ip[j4]; v[4 * j4] += t.x; v[4 * j4 + 1] += t.y; v[4 * j4 + 2] += t.z; v[4 * j4 + 3] += t.w; } }
#pragma unroll
        for (int j = 0; j < 32; ++j) { const bool forced = (j == 0) || (j == cur) || (j == cur - 1); v[j] = forced ? 1e9f : (j <= cur ? v[j] : NEG); }
        unsigned mask = 0u;
#pragma unroll
        for (int r8 = 0; r8 < 8; ++r8) { float best = NEG; int bi = -1;
#pragma unroll
            for (int j = 0; j < 32; ++j) { const bool free_ = !((mask >> j) & 1u); if (free_ && v[j] > best) { best = v[j]; bi = j; } }
            if (bi >= 0) mask |= 1u << bi; }
        SEL[r] = mask;
    }
    for (int r = gtid; r < M * 8; r += NT) {
        const int token = r >> 3, h = r & 7, b = token / SEQ, qpos = token % SEQ, cur = qpos >> 8;
        float q[64];
        load_q<64>(q, (const f16*)Z1 + (size_t)token * N1 + Z1_QD + h * 64, 0, 8);
        float gte[8];
#pragma unroll
        for (int n = 0; n < 8; ++n) { gte[n] = NEG;
            if (n < cur) { const float* km = KMEAN + (((size_t)b * 8 + n) * 8 + h) * 64; float s = 0.f;
#pragma unroll
                for (int d = 0; d < 64; ++d) s += q[d] * km[d];
                gte[n] = s; } }
        unsigned mask = 0u;
#pragma unroll
        for (int r3 = 0; r3 < 3; ++r3) { float best = NEG; int bi = -1;
#pragma unroll
            for (int n = 0; n < 8; ++n) { const bool free_ = !((mask >> n) & 1u); if (free_ && gte[n] > best) { best = gte[n]; bi = n; } }
            if (bi >= 0) mask |= 1u << bi; }
        MSEL[r] = mask;
    }
}
__device__ __forceinline__ void l1_attn_naive(const u16* Z1, const float* bias, const unsigned* SEL, const unsigned* MSEL, float* OCMP, u16* O, int wave, int lane) {
    for (int tb = blockIdx.x; tb < M / 64; tb += gridDim.x) {
        const int token = tb * 64 + lane, b = token / SEQ, qpos = token % SEQ, qmin = (tb * 64) % SEQ, head = wave, hkv = head >> 2;
        const f16* zb = (const f16*)Z1 + (size_t)b * SEQ * N1;
        const f16* zt = (const f16*)Z1 + (size_t)token * N1;
        float q[64], o[64];
        load_q<64>(q, zt + Z1_QC + head * 64, 0, 8);
        const float* bt = bias + (8 + head) * 2048;
        float* oc = OCMP + (size_t)token * 512 + head * 64;
#pragma unroll
        for (int d = 0; d < 64; ++d) o[d] = 0.f;
        float m = NEG, l = 0.f;
        const unsigned sel = SEL[token * 2 + hkv];
        const KeyZ kf{zb + Z1_KS + hkv * 64, zb + Z1_VS + hkv * 64, N1};
        auto sf = [&](int kp, float& s) -> bool { const int d = qpos - kp; if (d < 0 || !((sel >> (kp >> 6)) & 1u)) return false; s += bt[d]; return true; };
        naive_attend<64>(q, m, l, o, 0, qmin + 63, kf, sf);
        const float g0 = 1.0f / (1.0f + __expf(-(float)zt[Z1_GL + head])), g1 = 1.0f / (1.0f + __expf(-(float)zt[Z1_GL + 8 + head]));
        const float inv = g1 / l;
#pragma unroll
        for (int d = 0; d < 64; d += 4) { f32x4 t = *(f32x4*)(oc + d); t = t * g0 + (f32x4){o[d] * inv, o[d + 1] * inv, o[d + 2] * inv, o[d + 3] * inv}; *(f32x4*)(oc + d) = t; }
    }
    for (int tb = blockIdx.x; tb < M / 64; tb += gridDim.x) {
        const int token = tb * 64 + lane, b = token / SEQ, qpos = token % SEQ, qmin = (tb * 64) % SEQ, head = wave, hkv = head >> 2;
        const f16* zb = (const f16*)Z1 + (size_t)b * SEQ * N1;
        const f16* zt = (const f16*)Z1 + (size_t)token * N1;
        float q[64], o[64];
        load_q<64>(q, zt + Z1_QC + head * 64, 0, 8);
        const float* bt = bias + (8 + head) * 2048;
        const float* oc = OCMP + (size_t)token * 512 + head * 64;
#pragma unroll
        for (int d = 0; d < 64; ++d) o[d] = 0.f;
        float m = NEG, l = 0.f;
        const KeyZ kf{zb + Z1_KW + hkv * 64, zb + Z1_VW + hkv * 64, N1};
        auto sf = [&](int kp, float& s) -> bool { const int d = qpos - kp; if (d < 0 || d >= 256) return false; s += bt[d]; return true; };
        const int klo = qmin - 255 < 0 ? 0 : qmin - 255;
        naive_attend<64>(q, m, l, o, klo, qmin + 63, kf, sf);
        const float g2 = 1.0f / (1.0f + __expf(-(float)zt[Z1_GL + 16 + head]));
        const float inv = g2 / l;
#pragma unroll
        for (int d = 0; d < 64; d += 4) { const f32x4 t = *(const f32x4*)(oc + d); o[d] = t.x + o[d] * inv; o[d + 1] = t.y + o[d + 1] * inv; o[d + 2] = t.z + o[d + 2] * inv; o[d + 3] = t.w + o[d + 3] * inv; }
        store_o64(O + (size_t)token * DM + head * 64, o, 1.0f);
    }
    for (int tb = blockIdx.x; tb < M / 64; tb += gridDim.x) {
        const int token = tb * 64 + lane, b = token / SEQ, qpos = token % SEQ, qmin = (tb * 64) % SEQ, head = wave;
        const f16* zb = (const f16*)Z1 + (size_t)b * SEQ * N1;
        const f16* zt = (const f16*)Z1 + (size_t)token * N1;
        float q[64], o[64];
        load_q<64>(q, zt + Z1_QD + head * 64, 0, 8);
#pragma unroll
        for (int d = 0; d < 64; ++d) o[d] = 0.f;
        float m = NEG, l = 0.f;
        const unsigned msel = MSEL[token * 8 + head]; const int cur = qpos >> 8;
        const float* bt = bias + (16 + head) * 2048;
        const KeyZ kf{zb + Z1_KD + head * 64, zb + Z1_VD + head * 64, N1};
        auto sf = [&](int kp, float& s) -> bool { const int d = qpos - kp; const int kb = kp >> 8; if (d < 0 || !(kb == cur || ((msel >> kb) & 1u))) return false; s += bt[d]; return true; };
        naive_attend<64>(q, m, l, o, 0, qmin + 63, kf, sf);
        store_o64(O + (size_t)token * DM + 512 + head * 64, o, 1.0f / l);
    }
}

struct Args { const float* in[41]; float* out; unsigned char* ws; int ph_lo, ph_hi; };
enum { I_X = 0, I_REL = 1, I_L0 = 2, I_L1 = 21 };

__global__ void __launch_bounds__(NTHREADS, 2) fwd(Args args) {
    extern __shared__ __attribute__((aligned(16))) unsigned char lds_raw[];
    LAS unsigned char* lds = (LAS unsigned char*)lds_raw;
    volatile LAS unsigned* MISC = (volatile LAS unsigned*)(lds + MISC_OFF);
    const int tid = threadIdx.x, lane = tid & 63, wave = __builtin_amdgcn_readfirstlane(tid >> 6);
    const int G = gridDim.x, gw = blockIdx.x * NWAVES + wave, NGW = G * NWAVES, gtid = blockIdx.x * NTHREADS + tid, NT = G * NTHREADS;
    unsigned char* ws = args.ws;
    unsigned* ctl = (unsigned*)(ws + WS_CTL);
    for (int u = tid; u < (LDS_BYTES - RING_BYTES) / 4; u += NTHREADS) ((LAS unsigned*)(lds + RING_BYTES))[u] = 0u;
    __syncthreads();
#if ONE_LAUNCH
    XcdBarrier bar = xcd_barrier_post(ctl + 4096, MISC + 8);
#define GRID_BAR() xcd_barrier(bar)
#else
#define GRID_BAR() do {} while (0)
#endif
    const int lo = args.ph_lo, hi = args.ph_hi;
    int ph = 0;
#define IN_PH (lo <= ph && ph < hi)
#define SEAM() do { if (lo <= ph && ph + 1 < hi) GRID_BAR(); ++ph; } while (0)

    LAS float* scr = (LAS float*)(lds + wave * 16384);

#define PHASE(...) do { if (IN_PH) { __VA_ARGS__ } SEAM(); } while (0)
#define GEMM_SITE(EPI, Aptr, Bptr, NN, KK, LDA, ...) do { pg8::Gemm g{(const u16*)(Aptr), (const u16*)(Bptr), M, NN, KK, LDA}; pg8::StaticOrder S; S.init(M, NN, G, (int)blockIdx.x); \
        pg8::EPI E{__VA_ARGS__}; pg8::gemm_phase<pg8::EPI, pg8::StaticOrder, true>(lds, g, S, E); } while (0)
#define CONV_FFN(LBASE, F2BASE) do { \
        conv_matrix(args.in[LBASE + 2], DM, DFF, (u16*)(ws + W_GU1), DM, 1, scr, gw, NGW, lane); \
        conv_matrix(args.in[LBASE + 3], DM, DFF, (u16*)(ws + W_GU1), DM, 2, scr, gw, NGW, lane); \
        conv_matrix(args.in[LBASE + 4], DFF, DM, (u16*)(ws + W_D1), DFF, 0, scr, gw, NGW, lane); \
        conv_matrix(args.in[F2BASE + 2], DM, DFF, (u16*)(ws + W_GU2), DM, 1, scr, gw, NGW, lane); \
        conv_matrix(args.in[F2BASE + 3], DM, DFF, (u16*)(ws + W_GU2), DM, 2, scr, gw, NGW, lane); \
        conv_matrix(args.in[F2BASE + 4], DFF, DM, (u16*)(ws + W_D2), DFF, 0, scr, gw, NGW, lane); } while (0)
#define FFN_BLOCK(WGU, WD, POSTI, NEXTI, HASH) do { \
        PHASE( GEMM_SITE(EpiSwiglu, ws + WS_H, ws + WGU, NGU, DM, DM, (u16*)(ws + WS_ACT), DFF); ); \
        PHASE( GEMM_SITE(EpiF32, ws + WS_ACT, ws + WD, DM, DFF, DFF, (float*)(ws + WS_Y), DM); ); \
        PHASE( norm_rows<true, HASH>(args.out, (const float*)(ws + WS_Y), args.in[POSTI], 0.5f, args.out, HASH ? args.in[NEXTI] : nullptr, (u16*)(ws + WS_H), gw, NGW, lane); ); } while (0)
#define WOUT_BLOCK(POSTI, NEXTI) do { \
        PHASE( GEMM_SITE(EpiF32, ws + WS_H, ws + W_OUT, DM, DM, DM, (float*)(ws + WS_Y), DM); ); \
        PHASE( norm_rows<true, true>(args.out, (const float*)(ws + WS_Y), args.in[POSTI], 1.0f, args.out, args.in[NEXTI], (u16*)(ws + WS_H), gw, NGW, lane); ); } while (0)

    PHASE(
        CONV_FFN(I_L0, I_L0 + 14);
        conv_matrix(args.in[I_L0 + 7], DM, 1184, (u16*)(ws + W_IN), DM, 3, scr, gw, NGW, lane);
        zero_u32x4(ws + W_IN + (size_t)1184 * DM * 2, (size_t)(N0 - 1184) * DM * 2 / 16, gtid, NT);
        conv_matrix(args.in[I_L0 + 10], 256, 768, (u16*)(ws + W_UQ), 256, 5, scr, gw, NGW, lane);
        for (int i = gtid; i < 1024 * 16; i += NT) *(u32x4*)(ws + W_UKV + (size_t)(i >> 4) * 512 + 256 + (i & 15) * 16) = (u32x4){0u, 0u, 0u, 0u};
        conv_matrix(args.in[I_L0 + 12], 128, 1024, (u16*)(ws + W_UKV), 256, 0, scr, gw, NGW, lane);
        conv_matrix(args.in[I_L0 + 13], DM, DM, (u16*)(ws + W_OUT), DM, 0, scr, gw, NGW, lane);
        { float* BIAS = (float*)(ws + WS_BIAS); f32x2* ROPE = (f32x2*)(ws + WS_ROPE);
          for (int i = gtid; i < 24 * 2048; i += NT) { const int slot = i >> 11, d = i & 2047; BIAS[i] = args.in[I_REL][t5_bucket(d) * 24 + slot] * LOG2E; }
          for (int i = gtid; i < 2048 * 16; i += NT) { const int sp = i >> 4, jj = i & 15; const float inv = powf(10000.0f, -(float)(2 * jj) / 32.0f); const float ang = (float)sp * inv;
              ROPE[i] = (f32x2){(float)cos((double)ang), (float)sin((double)ang)}; } }
        norm_rows<false, true>(args.in[I_X], nullptr, nullptr, 0.f, args.out, args.in[I_L0 + 0], (u16*)(ws + WS_H), gw, NGW, lane);
    );
    FFN_BLOCK(W_GU1, W_D1, I_L0 + 1, I_L0 + 5, true);
    PHASE( GEMM_SITE(EpiF16, ws + WS_H, ws + W_IN, N0, DM, DM, (u16*)(ws + WS_Z), N0); );
    PHASE( mla_prep((const u16*)(ws + WS_Z), args.in[I_L0 + 9], args.in[I_L0 + 11], (const f32x2*)(ws + WS_ROPE), (u16*)(ws + WS_CQN), (u16*)(ws + WS_CKVN), (u16*)(ws + WS_KR), gw, NGW, lane); );
    PHASE( GEMM_SITE(EpiF16, ws + WS_CQN, ws + W_UQ, 768, 256, 256, (u16*)(ws + WS_QB), 768);
           GEMM_SITE(EpiF16, ws + WS_CKVN, ws + W_UKV, 1024, 256, 256, (u16*)(ws + WS_KVB), 1024); );
    PHASE( l0_attn_naive((const u16*)(ws + WS_Z), (const u16*)(ws + WS_QB), (const u16*)(ws + WS_KVB), (const u16*)(ws + WS_KR), (const float*)(ws + WS_BIAS), (const f32x2*)(ws + WS_ROPE), args.in[I_L0 + 8], (u16*)(ws + WS_H), wave, lane); );
    WOUT_BLOCK(I_L0 + 6, I_L0 + 14);
    FFN_BLOCK(W_GU2, W_D2, I_L0 + 15, I_L1 + 0, true);
    PHASE(
        CONV_FFN(I_L1, I_L1 + 15);
        conv_matrix(args.in[I_L1 + 7], DM, 2840, (u16*)(ws + W_IN), DM, 4, scr, gw, NGW, lane);
        zero_u32x4(ws + W_IN + (size_t)2840 * DM * 2, (size_t)(N1 - 2840) * DM * 2 / 16, gtid, NT);
        conv_matrix(args.in[I_L1 + 14], DM, DM, (u16*)(ws + W_OUT), DM, 0, scr, gw, NGW, lane);
    );
    FFN_BLOCK(W_GU1, W_D1, I_L1 + 1, I_L1 + 5, true);
    PHASE( GEMM_SITE(EpiF16, ws + WS_H, ws + W_IN, N1, DM, DM, (u16*)(ws + WS_Z), N1); );
    PHASE( l1_compress_hidden((const u16*)(ws + WS_Z), args.in[I_L1 + 8], args.in[I_L1 + 9], args.in[I_L1 + 10], args.in[I_L1 + 12], (float*)(ws + WS_HID), (float*)(ws + WS_KMEAN), gw, NGW, lane); );
    PHASE( l1_compress_out((const float*)(ws + WS_HID), args.in[I_L1 + 11], args.in[I_L1 + 13], (float*)(ws + WS_KCMP), (float*)(ws + WS_VCMP), gw, NGW, lane); );
    PHASE( l1_cmp_attn((const u16*)(ws + WS_Z), (const float*)(ws + WS_KCMP), (const float*)(ws + WS_VCMP), (float*)(ws + WS_OCMP), (float*)(ws + WS_IMP), wave, lane); );
    PHASE( l1_select((const u16*)(ws + WS_Z), (const float*)(ws + WS_IMP), (const float*)(ws + WS_KMEAN), (unsigned*)(ws + WS_SEL), (unsigned*)(ws + WS_MSEL), gtid, NT); );
    PHASE( l1_attn_naive((const u16*)(ws + WS_Z), (const float*)(ws + WS_BIAS), (const unsigned*)(ws + WS_SEL), (const unsigned*)(ws + WS_MSEL), (float*)(ws + WS_OCMP), (u16*)(ws + WS_H), wave, lane); );
    WOUT_BLOCK(I_L1 + 6, I_L1 + 15);
    FFN_BLOCK(W_GU2, W_D2, I_L1 + 16, 0, false);
}

constexpr int N_PHASES = 64;
extern "C" void kernel_launch(void* const* d_in, const int* in_sizes, int n_in, void* d_out, int out_size, void* d_ws, size_t ws_size, hipStream_t stream) {
    static int grid = 0;
    if (grid == 0) {
        if (n_in != 41 || out_size != M * DM || ws_size < WS_END) { fprintf(stderr, "kernel_launch: unexpected shapes (n_in %d out %d ws %zu)\n", n_in, out_size, ws_size); grid = -1; return; }
        int dev = 0, cus = 0;
        if (hipGetDevice(&dev) != hipSuccess || hipDeviceGetAttribute(&cus, hipDeviceAttributeMultiprocessorCount, dev) != hipSuccess) { grid = -1; return; }
        if (hipFuncSetAttribute((const void*)fwd, hipFuncAttributeMaxDynamicSharedMemorySize, LDS_BYTES) != hipSuccess) { grid = -1; return; }
        int per_cu = 0;
        (void)hipOccupancyMaxActiveBlocksPerMultiprocessor(&per_cu, (const void*)fwd, NTHREADS, LDS_BYTES);
        (void)hipGetLastError();
        grid = cus;
    }
    if (grid < 0) return;
    (void)hipMemsetAsync((char*)d_ws + WS_CTL, 0, CTL_ZERO_BYTES, stream);
    Args a{};
    for (int i = 0; i < 41; ++i) a.in[i] = (const float*)d_in[i];
    a.out = (float*)d_out; a.ws = (unsigned char*)d_ws;
#if ONE_LAUNCH
    a.ph_lo = 0; a.ph_hi = N_PHASES;
    hipLaunchKernelGGL(fwd, dim3(grid), dim3(NTHREADS), LDS_BYTES, stream, a);
#else
    for (int p = 0; p < 28; ++p) { a.ph_lo = p; a.ph_hi = p + 1; hipLaunchKernelGGL(fwd, dim3(grid), dim3(NTHREADS), LDS_BYTES, stream, a); }
#endif
}
```

```cpp
#include <hip/hip_runtime.h>
#include <cstdio>
#include <cstdint>

#ifndef ONE_LAUNCH
#define ONE_LAUNCH 1
#endif

#define LAS __attribute__((address_space(3)))
#define GAS __attribute__((address_space(1)))
typedef unsigned short u16;
typedef _Float16 f16;
typedef _Float16 f16x8 __attribute__((ext_vector_type(8)));
typedef _Float16 f16x4 __attribute__((ext_vector_type(4)));
typedef _Float16 f16x2 __attribute__((ext_vector_type(2)));
typedef float f32x4 __attribute__((ext_vector_type(4)));
typedef float f32x2 __attribute__((ext_vector_type(2)));
typedef unsigned u32x4 __attribute__((ext_vector_type(4)));
typedef unsigned u32x2 __attribute__((ext_vector_type(2)));

constexpr int BATCH = 8, SEQ = 2048, DM = 1024, M = BATCH * SEQ, DFF = 2816;
constexpr int NGU = 2 * DFF;
constexpr int N0 = 1280;
constexpr int N1 = 3072;
constexpr float EPS = 1e-6f;
constexpr float LOG2E = 1.4426950408889634f;
constexpr float QS = 0.125f * 1.4426950408889634f;
constexpr float QS96 = (float)(1.4426950408889634 / 9.797958971132712);
constexpr float NEG = -1e30f;
constexpr int Z0_QA = 0, Z0_KA = 512, Z0_VA = 640, Z0_CQ = 768, Z0_CKV = 1024, Z0_KR = 1152;
constexpr int Z1_QC = 0, Z1_KC = 512, Z1_VC = 640, Z1_KS = 768, Z1_VS = 896, Z1_KW = 1024, Z1_VW = 1152, Z1_QD = 1280, Z1_KD = 1792, Z1_VD = 2304, Z1_GL = 2816;
constexpr int NCMP = 127;

constexpr size_t MiB = 1u << 20;
constexpr size_t WS_CTL = 0, CTL_ZERO_BYTES = 1 * MiB;
constexpr size_t WS_BIAS = 1 * MiB;
constexpr size_t WS_ROPE = 1 * MiB + 256 * 1024;
constexpr size_t WS_PEB  = 1 * MiB + 768 * 1024;
constexpr size_t WS_W = 2 * MiB;
constexpr size_t W_GU1 = WS_W, W_D1 = W_GU1 + 11 * MiB, W_GU2 = W_D1 + 5632 * 1024, W_D2 = W_GU2 + 11 * MiB, W_IN = W_D2 + 5632 * 1024;
constexpr size_t W_OUT = W_IN + 6 * MiB, W_UQ = W_OUT + 2 * MiB, W_UKV = W_UQ + 512 * 1024, W_END = W_UKV + 512 * 1024;
constexpr size_t WS_H = 48 * MiB;
constexpr size_t WS_ACT = 80 * MiB;
constexpr size_t WS_Z = WS_ACT;
constexpr size_t WS_CQN = 120 * MiB, WS_CKVN = 128 * MiB, WS_KR = 136 * MiB, WS_QB = 137 * MiB;
constexpr size_t WS_Y = 176 * MiB;
constexpr size_t WS_KVB = WS_Y;
constexpr size_t WS_IMP = WS_Y;
constexpr size_t WS_OCMP = WS_Y + 16 * MiB;
constexpr size_t WS_MISC = 240 * MiB;
constexpr size_t WS_KCMP = WS_MISC, WS_VCMP = WS_MISC + 1 * MiB;
constexpr size_t WS_HID = WS_MISC + 2 * MiB;
constexpr size_t WS_SEL = WS_MISC + 8 * MiB;
constexpr size_t WS_MSEL = WS_MISC + 9 * MiB;
constexpr size_t WS_KMEAN = WS_MISC + 10 * MiB;
constexpr size_t WS_END = 256 * MiB;
static_assert(W_END <= WS_H && WS_QB + (size_t)M * 768 * 2 <= WS_Y && WS_OCMP + (size_t)M * 512 * 4 <= WS_MISC, "ws map");

constexpr int NWAVES = 8, NTHREADS = 512;
constexpr int LDS_BYTES = 147456;
constexpr int RING_BYTES = 131072;
constexpr int MISC_OFF = RING_BYTES + 320;

namespace pg8 {
constexpr int BM = 256, BK = 64, HALF = 128, HTB = HALF * BK * 2, STAGE_BYTES = 8 * HTB, NXCD = 8, WGM = 8;
__host__ __device__ __forceinline__ int lds_byte(int r, int c) { const int st = (r >> 4) * 2 + (c >> 5), rr = r & 15, cc = c & 31, ob = rr * 64 + cc * 2; return st * 1024 + (ob ^ (((ob >> 9) & 1) << 5)); }
__host__ __device__ __forceinline__ void stage_rc(int b, int& R, int& C) { const int st = b / 1024, sb = b % 1024, swz = sb ^ (((sb >> 9) & 1) << 5); R = (st >> 1) * 16 + swz / 64; C = (st & 1) * 32 + (swz % 64) / 2; }
__host__ __device__ __forceinline__ int perm32(int rho) { const int n = rho >> 4, i = rho & 15; return 8 * (i >> 2) + 4 * n + (i & 3); }

struct Unit { int pm, pn; };
struct Gemm { const u16* A; const u16* Bt; int M, N, K, lda; };

struct StaticOrder {
    int nM, nN, nwg, G, c;
    __host__ __device__ void init(int M_, int N_, int G_, int c_) { nM = M_ / BM; nN = N_ / BM; nwg = nM * nN; G = G_; c = c_; }
    __host__ __device__ bool next(int i, Unit& u) const {
        const long L = (long)i * G + c; if (L >= nwg) return false;
        int wgid = (int)L; { const int q = nwg / NXCD, r = nwg % NXCD, xcd = wgid % NXCD, off = wgid / NXCD; wgid = (xcd < r ? xcd * (q + 1) : r * (q + 1) + (xcd - r) * q) + off; }
        const int nig = WGM * nN, gid = wgid / nig, fm = gid * WGM, gsz = (nM - fm) < WGM ? (nM - fm) : WGM;
        u.pm = fm + ((wgid % nig) % gsz); u.pn = (wgid % nig) / gsz; return true;
    }
    __device__ __forceinline__ void a_ready(const Unit&) const {}
    __device__ __forceinline__ void done(const Unit&) const {}
};

__device__ __forceinline__ unsigned pk_f16(float lo, float hi) { f16x2 v = {(f16)lo, (f16)hi}; return __builtin_bit_cast(unsigned, v); }

struct EpiF16 {
    static constexpr bool PERM = true;
    u16* O; int ldc;
    __device__ __forceinline__ void operator()(const f32x4 (&acc)[2][2][4][2], const Unit& u, int wr, int wc, int fr, int fq) const {
        const int row0 = u.pm * BM + wr * 64 + fr, col0 = u.pn * BM + wc * 32 + 8 * fq;
#pragma unroll
        for (int ai = 0; ai < 2; ++ai)
#pragma unroll
            for (int m = 0; m < 4; ++m) { u16* rowp = O + (size_t)(row0 + ai * HALF + m * 16) * ldc + col0;
#pragma unroll
                for (int bj = 0; bj < 2; ++bj) { const f32x4 v0 = acc[ai][bj][m][0], v1 = acc[ai][bj][m][1];
                    u32x4 w; w.x = pk_f16(v0[0], v0[1]); w.y = pk_f16(v0[2], v0[3]); w.z = pk_f16(v1[0], v1[1]); w.w = pk_f16(v1[2], v1[3]);
                    *(u32x4*)(rowp + bj * HALF) = w; } }
    }
};
__device__ __forceinline__ float silu_mul(float g, float u) { return g * u * __builtin_amdgcn_rcpf(1.0f + __builtin_amdgcn_exp2f(-g * LOG2E)); }
struct EpiSwiglu {
    static constexpr bool PERM = true;
    u16* O; int ldc;
    __device__ __forceinline__ void operator()(const f32x4 (&acc)[2][2][4][2], const Unit& u, int wr, int wc, int fr, int fq) const {
        const int row0 = u.pm * BM + wr * 64 + fr, col0 = u.pn * HALF + wc * 32 + 8 * fq;
#pragma unroll
        for (int ai = 0; ai < 2; ++ai)
#pragma unroll
            for (int m = 0; m < 4; ++m) { u16* rowp = O + (size_t)(row0 + ai * HALF + m * 16) * ldc + col0;
                const f32x4 g0 = acc[ai][0][m][0], g1 = acc[ai][0][m][1], u0 = acc[ai][1][m][0], u1 = acc[ai][1][m][1];
                u32x4 w; w.x = pk_f16(silu_mul(g0[0], u0[0]), silu_mul(g0[1], u0[1])); w.y = pk_f16(silu_mul(g0[2], u0[2]), silu_mul(g0[3], u0[3]));
                w.z = pk_f16(silu_mul(g1[0], u1[0]), silu_mul(g1[1], u1[1])); w.w = pk_f16(silu_mul(g1[2], u1[2]), silu_mul(g1[3], u1[3]));
                *(u32x4*)rowp = w; }
    }
};
struct EpiF32 {
    static constexpr bool PERM = false;
    float* C; int ldc;
    __device__ __forceinline__ void operator()(const f32x4 (&acc)[2][2][4][2], const Unit& u, int wr, int wc, int fr, int fq) const {
        const int row0 = u.pm * BM + wr * 64 + fr, col0 = u.pn * BM + wc * 32 + 4 * fq;
#pragma unroll
        for (int ai = 0; ai < 2; ++ai)
#pragma unroll
            for (int m = 0; m < 4; ++m) { float* rowp = C + (size_t)(row0 + ai * HALF + m * 16) * ldc + col0;
#pragma unroll
                for (int bj = 0; bj < 2; ++bj)
#pragma unroll
                    for (int n = 0; n < 2; ++n) *(f32x4*)(rowp + bj * HALF + n * 16) = acc[ai][bj][m][n]; }
    }
};

template <class Epi, class Sched, bool ALIGN_EPI>
__device__ __forceinline__ void gemm_phase(LAS unsigned char* lds, const Gemm g, const Sched& S, const Epi& E) {
    const int tid = threadIdx.x, wid = __builtin_amdgcn_readfirstlane(tid >> 6), lane = tid & 63, wr = wid >> 2, wc = wid & 3, fr = lane & 15, fq = lane >> 4;
    const int K = g.K, nt = K / BK, lda = g.lda;
    unsigned voffA[2], voffB[2];
#pragma unroll
    for (int i = 0; i < 2; ++i) { int R, C; stage_rc(tid * 16 + i * 8192, R, C); const int Rb = Epi::PERM ? ((R & ~31) + perm32(R & 31)) : R;
        voffA[i] = (unsigned)(R * lda + C) * 2u; voffB[i] = (unsigned)(Rb * K + C) * 2u; }
    const size_t kstep = (size_t)(BK * 2);
    const size_t hstepA = (size_t)HALF * lda * 2, hstepB = (size_t)HALF * K * 2;
    const size_t tstepA = 2 * hstepA, tstepB = 2 * hstepB;
    const unsigned ldsw = (unsigned)wid * 1024u;
    const int aoff = lds_byte(wr * 64 + fr, fq * 8), boff = lds_byte(wc * 32 + fr, fq * 8);
#define PG8_SA(b, h) (((b) * 2 + (h)) * HTB)
#define PG8_SB(b, h) ((4 + (b) * 2 + (h)) * HTB)
#define PG8_STAGE(bufoff, gbase, voff) do { _Pragma("unroll") for (int _i = 0; _i < 2; ++_i) \
        __builtin_amdgcn_global_load_lds((const unsigned*)((const char*)(gbase) + (voff)[_i]), (LAS unsigned*)(lds + (bufoff) + ldsw + _i * 8192), 16, 0, 0); } while (0)
#define PG8_LDA(dst, b, h) do { _Pragma("unroll") for (int m = 0; m < 4; ++m) _Pragma("unroll") for (int k = 0; k < 2; ++k) dst[m][k] = *(const LAS f16x8*)(lds + PG8_SA(b, h) + aoff + m * 2048 + k * 1024); } while (0)
#define PG8_LDB(dst, b, h) do { _Pragma("unroll") for (int n = 0; n < 2; ++n) _Pragma("unroll") for (int k = 0; k < 2; ++k) dst[n][k] = *(const LAS f16x8*)(lds + PG8_SB(b, h) + boff + n * 2048 + k * 1024); } while (0)
#define PG8_MMA(ai, bj, At, Bt) do { __builtin_amdgcn_s_setprio(1); _Pragma("unroll") for (int m = 0; m < 4; ++m) _Pragma("unroll") for (int n = 0; n < 2; ++n) _Pragma("unroll") for (int k = 0; k < 2; ++k) \
        acc[ai][bj][m][n] = __builtin_amdgcn_mfma_f32_16x16x32_f16(Bt[n][k], At[m][k], acc[ai][bj][m][n], 0, 0, 0); __builtin_amdgcn_s_setprio(0); } while (0)
#define PG8_WAIT_V(n) asm volatile("s_waitcnt vmcnt(" #n ")" ::: "memory")
#define PG8_WAIT_L(n) asm volatile("s_waitcnt lgkmcnt(" #n ")" ::: "memory")
#define PG8_BAR __builtin_amdgcn_s_barrier()
#define PG8_SCHED __builtin_amdgcn_sched_barrier(0)
    Unit cur, nxt; int ui = 0;
    if (!S.next(0, cur)) return;
    f32x4 acc[2][2][4][2];
#pragma unroll
    for (int a = 0; a < 2; ++a)
#pragma unroll
        for (int b = 0; b < 2; ++b)
#pragma unroll
            for (int m = 0; m < 4; ++m)
#pragma unroll
                for (int n = 0; n < 2; ++n) acc[a][b][m][n] = (f32x4){0.f, 0.f, 0.f, 0.f};
    f16x8 At[4][2], B0[2][2], B1[2][2];
    const char* cA = (const char*)g.A + (size_t)cur.pm * tstepA; const char* cB = (const char*)g.Bt + (size_t)cur.pn * tstepB;
    S.a_ready(cur);
    PG8_STAGE(PG8_SB(0, 0), cB, voffB); PG8_STAGE(PG8_SB(0, 1), cB + hstepB, voffB); PG8_STAGE(PG8_SA(0, 0), cA, voffA); PG8_STAGE(PG8_SA(0, 1), cA + hstepA, voffA);
    if (wr == 1) PG8_BAR;
    PG8_WAIT_V(2); PG8_BAR;
    PG8_STAGE(PG8_SB(1, 0), cB + kstep, voffB); PG8_STAGE(PG8_SA(1, 0), cA + kstep, voffA); PG8_STAGE(PG8_SB(1, 1), cB + hstepB + kstep, voffB);
    PG8_WAIT_V(6); PG8_BAR;
    for (;;) {
        const bool has_next = S.next(ui + 1, nxt);
        const char* nA = has_next ? (const char*)g.A + (size_t)nxt.pm * tstepA : cA; const char* nB = has_next ? (const char*)g.Bt + (size_t)nxt.pn * tstepB : cB;
        for (int t = 0; t < nt; t += 2) {
            const bool last = (t == nt - 2);
            const char* a1 = cA + (size_t)(t + 1) * kstep;
            const char* a2 = last ? nA : cA + (size_t)(t + 2) * kstep; const char* b2 = last ? nB : cB + (size_t)(t + 2) * kstep;
            const char* a3 = a2 + kstep; const char* b3 = b2 + kstep;
            if (last && has_next) S.a_ready(nxt);
            PG8_LDB(B0, 0, 0); PG8_LDB(B1, 0, 1); PG8_SCHED; PG8_LDA(At, 0, 0); PG8_STAGE(PG8_SA(1, 1), a1 + hstepA, voffA);
            PG8_WAIT_V(8); PG8_WAIT_L(0); PG8_BAR; PG8_MMA(0, 0, At, B0); PG8_MMA(0, 1, At, B1); PG8_BAR; PG8_SCHED;
            PG8_LDA(At, 0, 1); PG8_STAGE(PG8_SB(0, 0), b2, voffB); PG8_STAGE(PG8_SB(0, 1), b2 + hstepB, voffB); PG8_STAGE(PG8_SA(0, 0), a2, voffA);
            PG8_WAIT_V(8); PG8_WAIT_L(0); PG8_BAR; PG8_MMA(1, 0, At, B0); PG8_MMA(1, 1, At, B1); PG8_BAR; PG8_SCHED;
            PG8_LDB(B0, 1, 0); PG8_LDB(B1, 1, 1); PG8_SCHED; PG8_LDA(At, 1, 0); PG8_STAGE(PG8_SA(0, 1), a2 + hstepA, voffA);
            PG8_WAIT_V(8); PG8_WAIT_L(0); PG8_BAR; PG8_MMA(0, 0, At, B0); PG8_MMA(0, 1, At, B1); PG8_BAR; PG8_SCHED;
            PG8_LDA(At, 1, 1); PG8_STAGE(PG8_SB(1, 0), b3, voffB); PG8_STAGE(PG8_SB(1, 1), b3 + hstepB, voffB); PG8_STAGE(PG8_SA(1, 0), a3, voffA);
            PG8_WAIT_V(8); PG8_WAIT_L(0); PG8_BAR; PG8_MMA(1, 0, At, B0); PG8_MMA(1, 1, At, B1); PG8_BAR; PG8_SCHED;
        }
        if constexpr (ALIGN_EPI) { if (wr == 0) PG8_BAR; }
        E(acc, cur, wr, wc, fr, fq); S.done(cur);
        if (!has_next) break;
#pragma unroll
        for (int a = 0; a < 2; ++a)
#pragma unroll
            for (int b = 0; b < 2; ++b)
#pragma unroll
                for (int m = 0; m < 4; ++m)
#pragma unroll
                    for (int n = 0; n < 2; ++n) acc[a][b][m][n] = (f32x4){0.f, 0.f, 0.f, 0.f};
        cur = nxt; cA = nA; cB = nB; ++ui;
        if constexpr (ALIGN_EPI) { if (wr == 1) PG8_BAR; }
    }
    PG8_WAIT_V(0);
    if constexpr (!ALIGN_EPI) { if (wr == 0) PG8_BAR; }
    PG8_BAR;
#undef PG8_SA
#undef PG8_SB
#undef PG8_STAGE
#undef PG8_LDA
#undef PG8_LDB
#undef PG8_MMA
#undef PG8_WAIT_V
#undef PG8_WAIT_L
#undef PG8_BAR
#undef PG8_SCHED
}
}

#define XB_TMO      128
#define XB_XCNT(j)  (256  + 64 * (j))
#define XB_XSUB(j)  (1280 + 64 * (j))
#define XB_XGEN(j)  (2304 + 64 * (j))
#define XB_TOP      3328
#define XB_TOPGEN   3392
#define XCD_BAR_WORDS 3456
#define XB_SPIN_CAP (1u << 23)
__device__ __forceinline__ unsigned xb_ld(unsigned* p)              { return __hip_atomic_load(p, __ATOMIC_RELAXED, __HIP_MEMORY_SCOPE_AGENT); }
__device__ __forceinline__ unsigned xb_add(unsigned* p, unsigned v) { return __hip_atomic_fetch_add(p, v, __ATOMIC_RELAXED, __HIP_MEMORY_SCOPE_AGENT); }
__device__ __forceinline__ unsigned xb_xcc_id() { return (unsigned)__builtin_amdgcn_s_getreg((3 << 11) | 20) & 0xFu; }
#define XB_SPIN(cond, bar) do { unsigned _sp = 0; while (cond) { __builtin_amdgcn_s_sleep(1); \
    if ((++_sp & 255u) == 0u) { if (xb_ld(&(bar)[XB_TMO])) break; if (_sp > XB_SPIN_CAP) { atomicAdd(&(bar)[XB_TMO], 1u); break; } } } } while (0)
struct XcdBarrier { unsigned* bar; unsigned x; volatile LAS unsigned* st; };
__device__ __forceinline__ XcdBarrier xcd_barrier_post(unsigned* bar, volatile LAS unsigned* st) {
    XcdBarrier b; b.bar = bar; b.x = xb_xcc_id(); b.st = st;
    if (threadIdx.x == 0) (void)xb_add(&bar[XB_XCNT(b.x)], 1u);
    return b;
}
__device__ __forceinline__ void xcd_barrier_complete(unsigned* bar, unsigned x, unsigned& nloc, unsigned& nx) {
    const unsigned G = gridDim.x * gridDim.y * gridDim.z;
    unsigned sum, cnt, mine, sp = 0u;
    for (;;) {
        sum = 0u; cnt = 0u; mine = 0u;
#pragma unroll
        for (unsigned j = 0; j < 16; ++j) { const unsigned c = xb_ld(&bar[XB_XCNT(j)]); sum += c; cnt += (c > 0u) ? 1u : 0u; mine = (j == x) ? c : mine; }
        if (sum == G) break;
        __builtin_amdgcn_s_sleep(1);
        if ((++sp & 255u) == 0u) { if (xb_ld(&bar[XB_TMO])) break; if (sp > XB_SPIN_CAP) { atomicAdd(&bar[XB_TMO], 1u); break; } }
    }
    nloc = mine > 0u ? mine : 1u; nx = cnt > 0u ? cnt : 1u;
}
__device__ __forceinline__ void xcd_barrier(const XcdBarrier& b) {
    asm volatile("s_waitcnt vmcnt(0)" ::: "memory");
    __syncthreads();
    if (threadIdx.x == 0) {
        unsigned* bar = b.bar;
        __builtin_amdgcn_s_waitcnt(0);
        unsigned nloc = b.st[0], nx = b.st[1];
        if (nloc == 0u) { xcd_barrier_complete(bar, b.x, nloc, nx); b.st[0] = nloc; b.st[1] = nx; }
        const unsigned old = xb_add(&bar[XB_XSUB(b.x)], 1u);
        const unsigned gen = old / nloc;
        if (old + 1u == (gen + 1u) * nloc) {
            __builtin_amdgcn_fence(__ATOMIC_RELEASE, "agent");
            asm volatile("s_waitcnt vmcnt(0)" ::: "memory");
            const unsigned og = xb_add(&bar[XB_TOP], 1u);
            const unsigned tg = og / nx;
            if (og + 1u == (tg + 1u) * nx) xb_add(&bar[XB_TOPGEN], 1u);
            else XB_SPIN(xb_ld(&bar[XB_TOPGEN]) == tg, bar);
            __builtin_amdgcn_fence(__ATOMIC_ACQUIRE, "agent");
            xb_add(&bar[XB_XGEN(b.x)], 1u);
            asm volatile("s_waitcnt vmcnt(0)" ::: "memory");
        } else {
            XB_SPIN(xb_ld(&bar[XB_XGEN(b.x)]) == gen, bar);
            __builtin_amdgcn_fence(__ATOMIC_ACQUIRE, "agent");
            asm volatile("s_waitcnt vmcnt(0)" ::: "memory");
        }
    }
    __syncthreads();
}

__device__ __forceinline__ float wave_sum(float v) {
#pragma unroll
    for (int o = 1; o < 64; o <<= 1) v += __shfl_xor(v, o);
    return v;
}
__device__ __forceinline__ int t5_bucket(int n) {
    if (n < 16) return n;
    int b = 16;
    b += (n >= 21); b += (n >= 27); b += (n >= 35); b += (n >= 46); b += (n >= 59); b += (n >= 77); b += (n >= 99); b += (n >= 128);
    b += (n >= 166); b += (n >= 216); b += (n >= 280); b += (n >= 363); b += (n >= 470); b += (n >= 609); b += (n >= 790);
    return b;
}

__device__ __forceinline__ int conv_row(int mode, int n) {
    if (mode == 1) return 256 * (n >> 7) + (n & 127);
    if (mode == 2) return 256 * (n >> 7) + 128 + (n & 127);
    if (mode == 4) return n < 1280 ? n : (n < 1304 ? 2816 + (n - 1280) : n - 24);
    return n;
}
__device__ __forceinline__ float conv_scale(int mode, int n) {
    if (mode == 3) return n < 512 ? QS : 1.0f;
    if (mode == 4) return (n < 512 || (n >= 1304 && n < 1816)) ? QS : 1.0f;
    if (mode == 5) return QS96;
    return 1.0f;
}
__device__ __forceinline__ void conv_matrix(const float* W, int K, int N, u16* WT, int ldk, int mode, LAS float* scr, int gw, int NGW, int lane) {
    const int nblk = (N + 31) / 32, nitems = (K / 64) * nblk;
    for (int item = gw; item < nitems; item += NGW) {
        const int kb = item / nblk, nb = item % nblk, k0 = 64 * kb, n0 = 32 * nb;
        const int nl = n0 + (lane & 31);
#pragma unroll 8
        for (int i = 0; i < 32; ++i) { const int kk = 2 * i + (lane >> 5); scr[kk * 33 + (lane & 31)] = (nl < N) ? W[(size_t)(k0 + kk) * N + nl] : 0.f; }
        asm volatile("s_waitcnt lgkmcnt(0)" ::: "memory");
        const int c = lane & 7;
#pragma unroll
        for (int j = 0; j < 4; ++j) { const int n = (lane >> 3) + 8 * j; const LAS float* s = scr + (8 * c) * 33 + n;
            if (n0 + n < N) { const float sc = conv_scale(mode, n0 + n);
                u32x4 o; o.x = pg8::pk_f16(s[0 * 33] * sc, s[1 * 33] * sc); o.y = pg8::pk_f16(s[2 * 33] * sc, s[3 * 33] * sc); o.z = pg8::pk_f16(s[4 * 33] * sc, s[5 * 33] * sc); o.w = pg8::pk_f16(s[6 * 33] * sc, s[7 * 33] * sc);
                *(u32x4*)(WT + (size_t)conv_row(mode, n0 + n) * ldk + k0 + 8 * c) = o; } }
        asm volatile("s_waitcnt lgkmcnt(0)" ::: "memory");
    }
}
__device__ __forceinline__ void zero_u32x4(void* p, size_t n16, int gtid, int NT) { for (size_t i = gtid; i < n16; i += NT) ((u32x4*)p)[i] = (u32x4){0u, 0u, 0u, 0u}; }

template <bool HASY, bool HASH>
__device__ __forceinline__ void norm_rows(const float* Xin, const float* Y, const float* post, float w, float* Xout, const float* pre, u16* H, int gw, int NGW, int lane) {
    for (int m = gw; m < M; m += NGW) {
        const f32x4* xr = (const f32x4*)(Xin + (size_t)m * DM) + lane;
        f32x4 x[4];
#pragma unroll
        for (int j = 0; j < 4; ++j) x[j] = xr[64 * j];
        if (HASY) {
            const f32x4* yr = (const f32x4*)(Y + (size_t)m * DM) + lane; f32x4 y[4]; float ss = 0.f;
#pragma unroll
            for (int j = 0; j < 4; ++j) { y[j] = yr[64 * j]; ss += (y[j].x * y[j].x + y[j].y * y[j].y) + (y[j].z * y[j].z + y[j].w * y[j].w); }
            const float rstd = 1.0f / sqrtf(wave_sum(ss) * (1.0f / DM) + EPS) * w;
#pragma unroll
            for (int j = 0; j < 4; ++j) { const f32x4 pg = ((const f32x4*)post)[lane + 64 * j]; x[j] = x[j] + y[j] * rstd * pg; }
        }
        f32x4* xo = (f32x4*)(Xout + (size_t)m * DM) + lane;
#pragma unroll
        for (int j = 0; j < 4; ++j) xo[64 * j] = x[j];
        if (HASH) {
            float ss = 0.f;
#pragma unroll
            for (int j = 0; j < 4; ++j) ss += (x[j].x * x[j].x + x[j].y * x[j].y) + (x[j].z * x[j].z + x[j].w * x[j].w);
            const float rstd = 1.0f / sqrtf(wave_sum(ss) * (1.0f / DM) + EPS);
            u32x2* ho = (u32x2*)(H + (size_t)m * DM) + lane;
#pragma unroll
            for (int j = 0; j < 4; ++j) { const f32x4 pg = ((const f32x4*)pre)[lane + 64 * j]; const f32x4 h = x[j] * rstd * pg;
                u32x2 o; o.x = pg8::pk_f16(h.x, h.y); o.y = pg8::pk_f16(h.z, h.w); ho[64 * j] = o; }
        }
    }
}

__device__ __forceinline__ void mla_prep(const u16* Z0, const float* qn, const float* kvn, const f32x2* rope, u16* CQN, u16* CKVN, u16* KRb, int gw, int NGW, int lane) {
    for (int m = gw; m < M; m += NGW) {
        const f16* z = (const f16*)Z0 + (size_t)m * N0;
        { const f16x4 c = *(const f16x4*)(z + Z0_CQ + 4 * lane); const float c0 = (float)c[0], c1 = (float)c[1], c2 = (float)c[2], c3 = (float)c[3];
          const float rstd = 1.0f / sqrtf(wave_sum((c0 * c0 + c1 * c1) + (c2 * c2 + c3 * c3)) * (1.0f / 256.f) + EPS);
          const f32x4 g = ((const f32x4*)qn)[lane];
          u32x2 o; o.x = pg8::pk_f16(c0 * rstd * g.x, c1 * rstd * g.y); o.y = pg8::pk_f16(c2 * rstd * g.z, c3 * rstd * g.w);
          *((u32x2*)(CQN + (size_t)m * 256) + lane) = o; }
        { const f16x2 c = *(const f16x2*)(z + Z0_CKV + 2 * lane); const float c0 = (float)c[0], c1 = (float)c[1];
          const float rstd = 1.0f / sqrtf(wave_sum(c0 * c0 + c1 * c1) * (1.0f / 128.f) + EPS);
          const f32x2 g = ((const f32x2*)kvn)[lane];
          unsigned* o = (unsigned*)(CKVN + (size_t)m * 256);
          o[lane] = pg8::pk_f16(c0 * rstd * g.x, c1 * rstd * g.y); o[64 + lane] = 0u; }
        if (lane < 16) { const float x1 = (float)z[Z0_KR + lane], x2 = (float)z[Z0_KR + 16 + lane]; const f32x2 cs = rope[(m & (SEQ - 1)) * 16 + lane];
          f16* o = (f16*)KRb + (size_t)m * 32; o[lane] = (f16)(x1 * cs.x - x2 * cs.y); o[16 + lane] = (f16)(x2 * cs.x + x1 * cs.y); }
    }
}

template <int DQK, class KeyFn, class ScoreFn>
__device__ __forceinline__ void naive_attend(const float (&q)[DQK], float& m, float& l, float (&o)[64], int klo, int khi, const KeyFn& kf, const ScoreFn& sf) {
    for (int kp = klo; kp <= khi; ++kp) {
        const f16x8* kr = (const f16x8*)kf.k(kp);
        float s = 0.f;
#pragma unroll
        for (int c = 0; c < 8; ++c) { const f16x8 kv = kr[c];
#pragma unroll
            for (int j = 0; j < 8; ++j) s += q[c * 8 + j] * (float)kv[j]; }
        if constexpr (DQK == 96) { const f16x8* k2 = (const f16x8*)kf.k2(kp);
#pragma unroll
            for (int c = 0; c < 4; ++c) { const f16x8 kv = k2[c];
#pragma unroll
                for (int j = 0; j < 8; ++j) s += q[64 + c * 8 + j] * (float)kv[j]; } }
        if (sf(kp, s)) {
            const float mn = fmaxf(m, s), a = __builtin_amdgcn_exp2f(m - mn), p = __builtin_amdgcn_exp2f(s - mn);
            m = mn; l = l * a + p;
            const f16x8* vr = (const f16x8*)kf.v(kp);
#pragma unroll
            for (int c = 0; c < 8; ++c) { const f16x8 vv = vr[c];
#pragma unroll
                for (int j = 0; j < 8; ++j) o[c * 8 + j] = o[c * 8 + j] * a + p * (float)vv[j]; }
        }
    }
}
struct KeyZ { const f16* kbase; const f16* vbase; int pitch;
    __device__ __forceinline__ const f16* k(int kp) const { return kbase + (size_t)kp * pitch; }
    __device__ __forceinline__ const f16* k2(int) const { return nullptr; }
    __device__ __forceinline__ const f16* v(int kp) const { return vbase + (size_t)kp * pitch; } };
struct KeyMLA { const f16* kvb; const f16* kr;
    __device__ __forceinline__ const f16* k(int kp) const { return kvb + (size_t)kp * 1024; }
    __device__ __forceinline__ const f16* k2(int kp) const { return kr + (size_t)kp * 32; }
    __device__ __forceinline__ const f16* v(int kp) const { return kvb + (size_t)kp * 1024 + 64; } };

__device__ __forceinline__ void store_o64(u16* dst, const float (&o)[64], float sc) {
#pragma unroll
    for (int c = 0; c < 8; ++c) { u32x4 w; w.x = pg8::pk_f16(o[c * 8 + 0] * sc, o[c * 8 + 1] * sc); w.y = pg8::pk_f16(o[c * 8 + 2] * sc, o[c * 8 + 3] * sc);
        w.z = pg8::pk_f16(o[c * 8 + 4] * sc, o[c * 8 + 5] * sc); w.w = pg8::pk_f16(o[c * 8 + 6] * sc, o[c * 8 + 7] * sc); ((u32x4*)dst)[c] = w; }
}
template <int N> __device__ __forceinline__ void load_q(float (&q)[N], const f16* src, int off, int cnt8) {
#pragma unroll
    for (int c = 0; c < cnt8; ++c) { const f16x8 v = ((const f16x8*)src)[c];
#pragma unroll
        for (int j = 0; j < 8; ++j) q[off + c * 8 + j] = (float)v[j]; }
}

__device__ __forceinline__ void l0_attn_naive(const u16* Z0, const u16* QBp, const u16* KVBp, const u16* KRp, const float* bias, const f32x2* rope, const float* sinks, u16* O, int wave, int lane) {
    for (int tb = blockIdx.x; tb < M / 64; tb += gridDim.x) {
        const int token = tb * 64 + lane, b = token / SEQ, qpos = token % SEQ, qmin = (tb * 64) % SEQ, head = wave, hkv = head >> 2;
        {
            float q[64], o[64];
            load_q<64>(q, (const f16*)Z0 + (size_t)token * N0 + Z0_QA + head * 64, 0, 8);
#pragma unroll
            for (int d = 0; d < 64; ++d) o[d] = 0.f;
            float m = sinks[head] * LOG2E, l = 1.f;
            const KeyZ kf{(const f16*)Z0 + (size_t)b * SEQ * N0 + Z0_KA + hkv * 64, (const f16*)Z0 + (size_t)b * SEQ * N0 + Z0_VA + hkv * 64, N0};
            const float* bt = bias + (0 + head) * 2048;
            auto sf = [&](int kp, float& s) -> bool { const int d = qpos - kp; if (d < 0 || d >= 128) return false; s += bt[d]; return true; };
            const int klo = qmin - 127 < 0 ? 0 : qmin - 127;
            naive_attend<64>(q, m, l, o, klo, qmin + 63, kf, sf);
            store_o64(O + (size_t)token * DM + head * 64, o, 1.0f / l);
        }
        {
            float q[96], o[64];
            load_q<96>(q, (const f16*)QBp + (size_t)token * 768 + head * 96, 0, 12);
#pragma unroll
            for (int i = 0; i < 16; ++i) { const f32x2 cs = rope[qpos * 16 + i]; const float x1 = q[64 + i], x2 = q[80 + i]; q[64 + i] = x1 * cs.x - x2 * cs.y; q[80 + i] = x2 * cs.x + x1 * cs.y; }
#pragma unroll
            for (int d = 0; d < 64; ++d) o[d] = 0.f;
            float m = NEG, l = 0.f;
            const KeyMLA kf{(const f16*)KVBp + (size_t)b * SEQ * 1024 + head * 128, (const f16*)KRp + (size_t)b * SEQ * 32};
            auto sf = [&](int kp, float&) -> bool { return kp <= qpos; };
            naive_attend<96>(q, m, l, o, 0, qmin + 63, kf, sf);
            store_o64(O + (size_t)token * DM + 512 + head * 64, o, 1.0f / l);
        }
    }
}

__device__ __forceinline__ void l1_compress_hidden(const u16* Z1, const float* pe_k, const float* pe_v, const float* wk1, const float* wv1, float* HID, float* KMEAN, int gw, int NGW, int lane) {
    const int nitems = 2 * BATCH * NCMP * 2 * 4;
    for (int it = gw; it < nitems; it += NGW) {
        const int nb = it & 3, row = (it >> 2) % (BATCH * NCMP * 2), sel = (it >> 2) / (BATCH * NCMP * 2);
        const int hkv = row & 1, c = (row >> 1) % NCMP, b = (row >> 1) / NCMP, n = nb * 64 + lane;
        const f16* x = (const f16*)Z1 + ((size_t)b * SEQ + 16 * c) * N1 + (sel ? Z1_VC : Z1_KC) + hkv * 64;
        const float* pe = sel ? pe_v : pe_k; const float* w1 = sel ? wv1 : wk1;
        float acc = 0.f;
        for (int i = 0; i < 32; ++i) {
            const f16* xr = x + (size_t)i * N1;
#pragma unroll 8
            for (int d = 0; d < 64; ++d) acc += ((float)xr[d] + pe[i * 64 + d]) * w1[(size_t)(i * 64 + d) * 256 + n];
        }
        HID[((size_t)sel * (BATCH * NCMP * 2) + row) * 256 + n] = acc / (1.0f + __expf(-acc));
    }
    for (int it = gw; it < BATCH * 8 * 8; it += NGW) {
        const int h = it & 7, nbk = (it >> 3) & 7, b = it >> 6;
        const f16* x = (const f16*)Z1 + ((size_t)b * SEQ + nbk * 256) * N1 + Z1_KD + h * 64 + lane;
        float s = 0.f;
        for (int t = 0; t < 256; ++t) s += (float)x[(size_t)t * N1];
        KMEAN[(size_t)it * 64 + lane] = s * (1.0f / 256.f);
    }
}
__device__ __forceinline__ void l1_compress_out(const float* HID, const float* wk2, const float* wv2, float* KCMP, float* VCMP, int gw, int NGW, int lane) {
    const int nrows = BATCH * NCMP * 2;
    for (int it = gw; it < 2 * nrows; it += NGW) {
        const int sel = it / nrows, row = it % nrows;
        const float* h = HID + ((size_t)sel * nrows + row) * 256; const float* w2 = sel ? wv2 : wk2;
        float acc = 0.f;
        for (int n = 0; n < 256; ++n) acc += h[n] * w2[n * 64 + lane];
        (sel ? VCMP : KCMP)[(size_t)row * 64 + lane] = acc;
    }
}
__device__ __forceinline__ void l1_cmp_attn(const u16* Z1, const float* KCMP, const float* VCMP, float* OCMP, float* IMP, int wave, int lane) {
    for (int tb = blockIdx.x; tb < M / 64; tb += gridDim.x) {
        const int token = tb * 64 + lane, b = token / SEQ, qpos = token % SEQ, qmin = (tb * 64) % SEQ, head = wave, hkv = head >> 2;
        float q[64], o[64];
        load_q<64>(q, (const f16*)Z1 + (size_t)token * N1 + Z1_QC + head * 64, 0, 8);
#pragma unroll
        for (int d = 0; d < 64; ++d) o[d] = 0.f;
        const int cmax = qpos >= 31 ? (qpos - 31) >> 4 : -1;
        const int cmaxw = (qmin + 63 - 31) >> 4;
        const float* kc = KCMP + ((size_t)b * NCMP * 2 + hkv) * 64; const float* vc = VCMP + ((size_t)b * NCMP * 2 + hkv) * 64;
        float m = NEG, l = 0.f;
        for (int c = 0; c <= cmaxw && c < NCMP; ++c) {
            const float* kr = kc + (size_t)c * 128; float s = 0.f;
#pragma unroll
            for (int d = 0; d < 64; ++d) s += q[d] * kr[d];
            if (c <= cmax) { const float mn = fmaxf(m, s), a = __builtin_amdgcn_exp2f(m - mn), p = __builtin_amdgcn_exp2f(s - mn); m = mn; l = l * a + p;
                const float* vr = vc + (size_t)c * 128;
#pragma unroll
                for (int d = 0; d < 64; ++d) o[d] = o[d] * a + p * vr[d]; }
        }
        const float inv = l > 0.f ? 1.0f / l : 0.f;
        float* op = OCMP + (size_t)token * 512 + head * 64;
#pragma unroll
        for (int d = 0; d < 64; d += 4) *(f32x4*)(op + d) = (f32x4){o[d] * inv, o[d + 1] * inv, o[d + 2] * inv, o[d + 3] * inv};
        float* ip = IMP + ((size_t)token * 8 + head) * 32;
        for (int j = 0; j < 32; ++j) {
            float acc = 0.f;
            if (4 * j - 1 <= cmaxw) {
#pragma unroll
                for (int cc = -1; cc < 4; ++cc) { const int c = 4 * j + cc;
                    if (c >= 0 && c < NCMP && c <= cmaxw) { const float* kr = kc + (size_t)c * 128; float s = 0.f;
#pragma unroll
                        for (int d = 0; d < 64; ++d) s += q[d] * kr[d];
                        if (c <= cmax) acc += __builtin_amdgcn_exp2f(s - m) * inv; } }
            }
            ip[j] = acc;
        }
    }
}
__device__ __forceinline__ void l1_select(const u16* Z1, const float* IMP, const float* KMEAN, unsigned* SEL, unsigned* MSEL, int gtid, int NT) {
    for (int r = gtid; r < M * 2; r += NT) {
        const int token = r >> 1, hkv = r & 1, qpos = token % SEQ, cur = qpos >> 6;
        float v[32];
#pragma unroll
        for (int j = 0; j < 32; ++j) v[j] = 0.f;
#pragma unroll
        for (int g = 0; g < 4; ++g) { const f32x4* ip = (const f32x4*)(IMP + ((size_t)token * 8 + hkv * 4 + g) * 32);
#pragma unroll
            for (int j4 = 0; j4 < 8; ++j4) { const f32x4 t = ip[j4]; v[4 * j4] += t.x; v[4 * j4 + 1] += t.y; v[4 * j4 + 2] += t.z; v[4 * j4 + 3] += t.w; } }
#pragma unroll
        for (int j = 0; j < 32; ++j) { const bool forced = (j == 0) || (j == cur) || (j == cur - 1); v[j] = forced ? 1e9f : (j <= cur ? v[j] : NEG); }
        unsigned mask = 0u;
#pragma unroll
        for (int r8 = 0; r8 < 8; ++r8) { float best = NEG; int bi = -1;
#pragma unroll
            for (int j = 0; j < 32; ++j) { const bool free_ = !((mask >> j) & 1u); if (free_ && v[j] > best) { best = v[j]; bi = j; } }
            if (bi >= 0) mask |= 1u << bi; }
        SEL[r] = mask;
    }
    for (int r = gtid; r < M * 8; r += NT) {
        const int token = r >> 3, h = r & 7, b = token / SEQ, qpos = token % SEQ, cur = qpos >> 8;
        float q[64];
        load_q<64>(q, (const f16*)Z1 + (size_t)token * N1 + Z1_QD + h * 64, 0, 8);
        float gte[8];
#pragma unroll
        for (int n = 0; n < 8; ++n) { gte[n] = NEG;
            if (n < cur) { const float* km = KMEAN + (((size_t)b * 8 + n) * 8 + h) * 64; float s = 0.f;
#pragma unroll
                for (int d = 0; d < 64; ++d) s += q[d] * km[d];
                gte[n] = s; } }
        unsigned mask = 0u;
#pragma unroll
        for (int r3 = 0; r3 < 3; ++r3) { float best = NEG; int bi = -1;
#pragma unroll
            for (int n = 0; n < 8; ++n) { const bool free_ = !((mask >> n) & 1u); if (free_ && gte[n] > best) { best = gte[n]; bi = n; } }
            if (bi >= 0) mask |= 1u << bi; }
        MSEL[r] = mask;
    }
}
__device__ __forceinline__ void l1_attn_naive(const u16* Z1, const float* bias, const unsigned* SEL, const unsigned* MSEL, float* OCMP, u16* O, int wave, int lane) {
    for (int tb = blockIdx.x; tb < M / 64; tb += gridDim.x) {
        const int token = tb * 64 + lane, b = token / SEQ, qpos = token % SEQ, qmin = (tb * 64) % SEQ, head = wave, hkv = head >> 2;
        const f16* zb = (const f16*)Z1 + (size_t)b * SEQ * N1;
        const f16* zt = (const f16*)Z1 + (size_t)token * N1;
        float q[64], o[64];
        load_q<64>(q, zt + Z1_QC + head * 64, 0, 8);
        const float* bt = bias + (8 + head) * 2048;
        float* oc = OCMP + (size_t)token * 512 + head * 64;
#pragma unroll
        for (int d = 0; d < 64; ++d) o[d] = 0.f;
        float m = NEG, l = 0.f;
        const unsigned sel = SEL[token * 2 + hkv];
        const KeyZ kf{zb + Z1_KS + hkv * 64, zb + Z1_VS + hkv * 64, N1};
        auto sf = [&](int kp, float& s) -> bool { const int d = qpos - kp; if (d < 0 || !((sel >> (kp >> 6)) & 1u)) return false; s += bt[d]; return true; };
        naive_attend<64>(q, m, l, o, 0, qmin + 63, kf, sf);
        const float g0 = 1.0f / (1.0f + __expf(-(float)zt[Z1_GL + head])), g1 = 1.0f / (1.0f + __expf(-(float)zt[Z1_GL + 8 + head]));
        const float inv = g1 / l;
#pragma unroll
        for (int d = 0; d < 64; d += 4) { f32x4 t = *(f32x4*)(oc + d); t = t * g0 + (f32x4){o[d] * inv, o[d + 1] * inv, o[d + 2] * inv, o[d + 3] * inv}; *(f32x4*)(oc + d) = t; }
    }
    for (int tb = blockIdx.x; tb < M / 64; tb += gridDim.x) {
        const int token = tb * 64 + lane, b = token / SEQ, qpos = token % SEQ, qmin = (tb * 64) % SEQ, head = wave, hkv = head >> 2;
        const f16* zb = (const f16*)Z1 + (size_t)b * SEQ * N1;
        const f16* zt = (const f16*)Z1 + (size_t)token * N1;
        float q[64], o[64];
        load_q<64>(q, zt + Z1_QC + head * 64, 0, 8);
        const float* bt = bias + (8 + head) * 2048;
        const float* oc = OCMP + (size_t)token * 512 + head * 64;
#pragma unroll
        for (int d = 0; d < 64; ++d) o[d] = 0.f;
        float m = NEG, l = 0.f;
        const KeyZ kf{zb + Z1_KW + hkv * 64, zb + Z1_VW + hkv * 64, N1};
        auto sf = [&](int kp, float& s) -> bool { const int d = qpos - kp; if (d < 0 || d >= 256) return false; s += bt[d]; return true; };
        const int klo = qmin - 255 < 0 ? 0 : qmin - 255;
        naive_attend<64>(q, m, l, o, klo, qmin + 63, kf, sf);
        const float g2 = 1.0f / (1.0f + __expf(-(float)zt[Z1_GL + 16 + head]));
        const float inv = g2 / l;
#pragma unroll
        for (int d = 0; d < 64; d += 4) { const f32x4 t = *(const f32x4*)(oc + d); o[d] = t.x + o[d] * inv; o[d + 1] = t.y + o[d + 1] * inv; o[d + 2] = t.z + o[d + 2] * inv; o[d + 3] = t.w + o[d + 3] * inv; }
        store_o64(O + (size_t)token * DM + head * 64, o, 1.0f);
    }
    for (int tb = blockIdx.x; tb < M / 64; tb += gridDim.x) {
        const int token = tb * 64 + lane, b = token / SEQ, qpos = token % SEQ, qmin = (tb * 64) % SEQ, head = wave;
        const f16* zb = (const f16*)Z1 + (size_t)b * SEQ * N1;
        const f16* zt = (const f16*)Z1 + (size_t)token * N1;
        float q[64], o[64];
        load_q<64>(q, zt + Z1_QD + head * 64, 0, 8);
#pragma unroll
        for (int d = 0; d < 64; ++d) o[d] = 0.f;
        float m = NEG, l = 0.f;
        const unsigned msel = MSEL[token * 8 + head]; const int cur = qpos >> 8;
        const float* bt = bias + (16 + head) * 2048;
        const KeyZ kf{zb + Z1_KD + head * 64, zb + Z1_VD + head * 64, N1};
        auto sf = [&](int kp, float& s) -> bool { const int d = qpos - kp; const int kb = kp >> 8; if (d < 0 || !(kb == cur || ((msel >> kb) & 1u))) return false; s += bt[d]; return true; };
        naive_attend<64>(q, m, l, o, 0, qmin + 63, kf, sf);
        store_o64(O + (size_t)token * DM + 512 + head * 64, o, 1.0f / l);
    }
}

struct Args { const float* in[41]; float* out; unsigned char* ws; int ph_lo, ph_hi; };
enum { I_X = 0, I_REL = 1, I_L0 = 2, I_L1 = 21 };

__global__ void __launch_bounds__(NTHREADS, 2) fwd(Args args) {
    extern __shared__ __attribute__((aligned(16))) unsigned char lds_raw[];
    LAS unsigned char* lds = (LAS unsigned char*)lds_raw;
    volatile LAS unsigned* MISC = (volatile LAS unsigned*)(lds + MISC_OFF);
    const int tid = threadIdx.x, lane = tid & 63, wave = __builtin_amdgcn_readfirstlane(tid >> 6);
    const int G = gridDim.x, gw = blockIdx.x * NWAVES + wave, NGW = G * NWAVES, gtid = blockIdx.x * NTHREADS + tid, NT = G * NTHREADS;
    unsigned char* ws = args.ws;
    unsigned* ctl = (unsigned*)(ws + WS_CTL);
    for (int u = tid; u < (LDS_BYTES - RING_BYTES) / 4; u += NTHREADS) ((LAS unsigned*)(lds + RING_BYTES))[u] = 0u;
    __syncthreads();
#if ONE_LAUNCH
    XcdBarrier bar = xcd_barrier_post(ctl + 4096, MISC + 8);
#define GRID_BAR() xcd_barrier(bar)
#else
#define GRID_BAR() do {} while (0)
#endif
    const int lo = args.ph_lo, hi = args.ph_hi;
    int ph = 0;
#define IN_PH (lo <= ph && ph < hi)
#define SEAM() do { if (lo <= ph && ph + 1 < hi) GRID_BAR(); ++ph; } while (0)

    LAS float* scr = (LAS float*)(lds + wave * 16384);

#define PHASE(...) do { if (IN_PH) { __VA_ARGS__ } SEAM(); } while (0)
#define GEMM_SITE(EPI, Aptr, Bptr, NN, KK, LDA, ...) do { pg8::Gemm g{(const u16*)(Aptr), (const u16*)(Bptr), M, NN, KK, LDA}; pg8::StaticOrder S; S.init(M, NN, G, (int)blockIdx.x); \
        pg8::EPI E{__VA_ARGS__}; pg8::gemm_phase<pg8::EPI, pg8::StaticOrder, true>(lds, g, S, E); } while (0)
#define CONV_FFN(LBASE, F2BASE) do { \
        conv_matrix(args.in[LBASE + 2], DM, DFF, (u16*)(ws + W_GU1), DM, 1, scr, gw, NGW, lane); \
        conv_matrix(args.in[LBASE + 3], DM, DFF, (u16*)(ws + W_GU1), DM, 2, scr, gw, NGW, lane); \
        conv_matrix(args.in[LBASE + 4], DFF, DM, (u16*)(ws + W_D1), DFF, 0, scr, gw, NGW, lane); \
        conv_matrix(args.in[F2BASE + 2], DM, DFF, (u16*)(ws + W_GU2), DM, 1, scr, gw, NGW, lane); \
        conv_matrix(args.in[F2BASE + 3], DM, DFF, (u16*)(ws + W_GU2), DM, 2, scr, gw, NGW, lane); \
        conv_matrix(args.in[F2BASE + 4], DFF, DM, (u16*)(ws + W_D2), DFF, 0, scr, gw, NGW, lane); } while (0)
#define FFN_BLOCK(WGU, WD, POSTI, NEXTI, HASH) do { \
        PHASE( GEMM_SITE(EpiSwiglu, ws + WS_H, ws + WGU, NGU, DM, DM, (u16*)(ws + WS_ACT), DFF); ); \
        PHASE( GEMM_SITE(EpiF32, ws + WS_ACT, ws + WD, DM, DFF, DFF, (float*)(ws + WS_Y), DM); ); \
        PHASE( norm_rows<true, HASH>(args.out, (const float*)(ws + WS_Y), args.in[POSTI], 0.5f, args.out, HASH ? args.in[NEXTI] : nullptr, (u16*)(ws + WS_H), gw, NGW, lane); ); } while (0)
#define WOUT_BLOCK(POSTI, NEXTI) do { \
        PHASE( GEMM_SITE(EpiF32, ws + WS_H, ws + W_OUT, DM, DM, DM, (float*)(ws + WS_Y), DM); ); \
        PHASE( norm_rows<true, true>(args.out, (const float*)(ws + WS_Y), args.in[POSTI], 1.0f, args.out, args.in[NEXTI], (u16*)(ws + WS_H), gw, NGW, lane); ); } while (0)

    PHASE(
        CONV_FFN(I_L0, I_L0 + 14);
        conv_matrix(args.in[I_L0 + 7], DM, 1184, (u16*)(ws + W_IN), DM, 3, scr, gw, NGW, lane);
        zero_u32x4(ws + W_IN + (size_t)1184 * DM * 2, (size_t)(N0 - 1184) * DM * 2 / 16, gtid, NT);
        conv_matrix(args.in[I_L0 + 10], 256, 768, (u16*)(ws + W_UQ), 256, 5, scr, gw, NGW, lane);
        for (int i = gtid; i < 1024 * 16; i += NT) *(u32x4*)(ws + W_UKV + (size_t)(i >> 4) * 512 + 256 + (i & 15) * 16) = (u32x4){0u, 0u, 0u, 0u};
        conv_matrix(args.in[I_L0 + 12], 128, 1024, (u16*)(ws + W_UKV), 256, 0, scr, gw, NGW, lane);
        conv_matrix(args.in[I_L0 + 13], DM, DM, (u16*)(ws + W_OUT), DM, 0, scr, gw, NGW, lane);
        { float* BIAS = (float*)(ws + WS_BIAS); f32x2* ROPE = (f32x2*)(ws + WS_ROPE);
          for (int i = gtid; i < 24 * 2048; i += NT) { const int slot = i >> 11, d = i & 2047; BIAS[i] = args.in[I_REL][t5_bucket(d) * 24 + slot] * LOG2E; }
          for (int i = gtid; i < 2048 * 16; i += NT) { const int sp = i >> 4, jj = i & 15; const float inv = powf(10000.0f, -(float)(2 * jj) / 32.0f); const float ang = (float)sp * inv;
              ROPE[i] = (f32x2){(float)cos((double)ang), (float)sin((double)ang)}; } }
        norm_rows<false, true>(args.in[I_X], nullptr, nullptr, 0.f, args.out, args.in[I_L0 + 0], (u16*)(ws + WS_H), gw, NGW, lane);
    );
    FFN_BLOCK(W_GU1, W_D1, I_L0 + 1, I_L0 + 5, true);
    PHASE( GEMM_SITE(EpiF16, ws + WS_H, ws + W_IN, N0, DM, DM, (u16*)(ws + WS_Z), N0); );
    PHASE( mla_prep((const u16*)(ws + WS_Z), args.in[I_L0 + 9], args.in[I_L0 + 11], (const f32x2*)(ws + WS_ROPE), (u16*)(ws + WS_CQN), (u16*)(ws + WS_CKVN), (u16*)(ws + WS_KR), gw, NGW, lane); );
    PHASE( GEMM_SITE(EpiF16, ws + WS_CQN, ws + W_UQ, 768, 256, 256, (u16*)(ws + WS_QB), 768);
           GEMM_SITE(EpiF16, ws + WS_CKVN, ws + W_UKV, 1024, 256, 256, (u16*)(ws + WS_KVB), 1024); );
    PHASE( l0_attn_naive((const u16*)(ws + WS_Z), (const u16*)(ws + WS_QB), (const u16*)(ws + WS_KVB), (const u16*)(ws + WS_KR), (const float*)(ws + WS_BIAS), (const f32x2*)(ws + WS_ROPE), args.in[I_L0 + 8], (u16*)(ws + WS_H), wave, lane); );
    WOUT_BLOCK(I_L0 + 6, I_L0 + 14);
    FFN_BLOCK(W_GU2, W_D2, I_L0 + 15, I_L1 + 0, true);
    PHASE(
        CONV_FFN(I_L1, I_L1 + 15);
        conv_matrix(args.in[I_L1 + 7], DM, 2840, (u16*)(ws + W_IN), DM, 4, scr, gw, NGW, lane);
        zero_u32x4(ws + W_IN + (size_t)2840 * DM * 2, (size_t)(N1 - 2840) * DM * 2 / 16, gtid, NT);
        conv_matrix(args.in[I_L1 + 14], DM, DM, (u16*)(ws + W_OUT), DM, 0, scr, gw, NGW, lane);
    );
    FFN_BLOCK(W_GU1, W_D1, I_L1 + 1, I_L1 + 5, true);
    PHASE( GEMM_SITE(EpiF16, ws + WS_H, ws + W_IN, N1, DM, DM, (u16*)(ws + WS_Z), N1); );
    PHASE( l1_compress_hidden((const u16*)(ws + WS_Z), args.in[I_L1 + 8], args.in[I_L1 + 9], args.in[I_L1 + 10], args.in[I_L1 + 12], (float*)(ws + WS_HID), (float*)(ws + WS_KMEAN), gw, NGW, lane); );
    PHASE( l1_compress_out((const float*)(ws + WS_HID), args.in[I_L1 + 11], args.in[I_L1 + 13], (float*)(ws + WS_KCMP), (float*)(ws + WS_VCMP), gw, NGW, lane); );
    PHASE( l1_cmp_attn((const u16*)(ws + WS_Z), (const float*)(ws + WS_KCMP), (const float*)(ws + WS_VCMP), (float*)(ws + WS_OCMP), (float*)(ws + WS_IMP), wave, lane); );
    PHASE( l1_select((const u16*)(ws + WS_Z), (const float*)(ws + WS_IMP), (const float*)(ws + WS_KMEAN), (unsigned*)(ws + WS_SEL), (unsigned*)(ws + WS_MSEL), gtid, NT); );
    PHASE( l1_attn_naive((const u16*)(ws + WS_Z), (const float*)(ws + WS_BIAS), (const unsigned*)(ws + WS_SEL), (const unsigned*)(ws + WS_MSEL), (float*)(ws + WS_OCMP), (u16*)(ws + WS_H), wave, lane); );
    WOUT_BLOCK(I_L1 + 6, I_L1 + 15);
    FFN_BLOCK(W_GU2, W_D2, I_L1 + 16, 0, false);
}

constexpr int N_PHASES = 64;
extern "C" void kernel_launch(void* const* d_in, const int* in_sizes, int n_in, void* d_out, int out_size, void* d_ws, size_t ws_size, hipStream_t stream) {
    static int grid = 0;
    if (grid == 0) {
        if (n_in != 41 || out_size != M * DM || ws_size < WS_END) { fprintf(stderr, "kernel_launch: unexpected shapes (n_in %d out %d ws %zu)\n", n_in, out_size, ws_size); grid = -1; return; }
        int dev = 0, cus = 0;
        if (hipGetDevice(&dev) != hipSuccess || hipDeviceGetAttribute(&cus, hipDeviceAttributeMultiprocessorCount, dev) != hipSuccess) { grid = -1; return; }
        if (hipFuncSetAttribute((const void*)fwd, hipFuncAttributeMaxDynamicSharedMemorySize, LDS_BYTES) != hipSuccess) { grid = -1; return; }
        int per_cu = 0;
        (void)hipOccupancyMaxActiveBlocksPerMultiprocessor(&per_cu, (const void*)fwd, NTHREADS, LDS_BYTES);
        (void)hipGetLastError();
        grid = cus;
    }
    if (grid < 0) return;
    (void)hipMemsetAsync((char*)d_ws + WS_CTL, 0, CTL_ZERO_BYTES, stream);
    Args a{};
    for (int i = 0; i < 41; ++i) a.in[i] = (const float*)d_in[i];
    a.out = (float*)d_out; a.ws = (unsigned char*)d_ws;
#if ONE_LAUNCH
    a.ph_lo = 0; a.ph_hi = N_PHASES;
    hipLaunchKernelGGL(fwd, dim3(grid), dim3(NTHREADS), LDS_BYTES, stream, a);
#else
    for (int p = 0; p < 28; ++p) { a.ph_lo = p; a.ph_hi = p + 1; hipLaunchKernelGGL(fwd, dim3(grid), dim3(NTHREADS), LDS_BYTES, stream, a); }
#endif
}
```

```cpp
#include <hip/hip_runtime.h>
#include <cstdio>
#include <cstdint>

#ifndef ONE_LAUNCH
#define ONE_LAUNCH 1
#endif

#define LAS __attribute__((address_space(3)))
#define GAS __attribute__((address_space(1)))
typedef unsigned short u16;
typedef _Float16 f16;
typedef _Float16 f16x8 __attribute__((ext_vector_type(8)));
typedef _Float16 f16x4 __attribute__((ext_vector_type(4)));
typedef _Float16 f16x2 __attribute__((ext_vector_type(2)));
typedef float f32x4 __attribute__((ext_vector_type(4)));
typedef float f32x2 __attribute__((ext_vector_type(2)));
typedef unsigned u32x4 __attribute__((ext_vector_type(4)));
typedef unsigned u32x2 __attribute__((ext_vector_type(2)));

constexpr int BATCH = 8, SEQ = 2048, DM = 1024, M = BATCH * SEQ, DFF = 2816;
constexpr int NGU = 2 * DFF;
constexpr int N0 = 1280;
constexpr int N1 = 3072;
constexpr float EPS = 1e-6f;
constexpr float LOG2E = 1.4426950408889634f;
constexpr float QS = 0.125f * 1.4426950408889634f;
constexpr float QS96 = (float)(1.4426950408889634 / 9.797958971132712);
constexpr float NEG = -1e30f;
constexpr int Z0_QA = 0, Z0_KA = 512, Z0_VA = 640, Z0_CQ = 768, Z0_CKV = 1024, Z0_KR = 1152;
constexpr int Z1_QC = 0, Z1_KC = 512, Z1_VC = 640, Z1_KS = 768, Z1_VS = 896, Z1_KW = 1024, Z1_VW = 1152, Z1_QD = 1280, Z1_KD = 1792, Z1_VD = 2304, Z1_GL = 2816;
constexpr int NCMP = 127;

constexpr size_t MiB = 1u << 20;
constexpr size_t WS_CTL = 0, CTL_ZERO_BYTES = 1 * MiB;
constexpr size_t WS_BIAS = 1 * MiB;
constexpr size_t WS_ROPE = 1 * MiB + 256 * 1024;
constexpr size_t WS_PEB  = 1 * MiB + 768 * 1024;
constexpr size_t WS_W = 2 * MiB;
constexpr size_t W_GU1 = WS_W, W_D1 = W_GU1 + 11 * MiB, W_GU2 = W_D1 + 5632 * 1024, W_D2 = W_GU2 + 11 * MiB, W_IN = W_D2 + 5632 * 1024;
constexpr size_t W_OUT = W_IN + 6 * MiB, W_UQ = W_OUT + 2 * MiB, W_UKV = W_UQ + 512 * 1024, W_END = W_UKV + 512 * 1024;
constexpr size_t WS_H = 48 * MiB;
constexpr size_t WS_ACT = 80 * MiB;
constexpr size_t WS_Z = WS_ACT;
constexpr size_t WS_CQN = 120 * MiB, WS_CKVN = 128 * MiB, WS_KR = 136 * MiB, WS_QB = 137 * MiB;
constexpr size_t WS_Y = 176 * MiB;
constexpr size_t WS_KVB = WS_Y;
constexpr size_t WS_IMP = WS_Y;
constexpr size_t WS_OCMP = WS_Y + 16 * MiB;
constexpr size_t WS_MISC = 240 * MiB;
constexpr size_t WS_KCMP = WS_MISC, WS_VCMP = WS_MISC + 1 * MiB;
constexpr size_t WS_HID = WS_MISC + 2 * MiB;
constexpr size_t WS_SEL = WS_MISC + 8 * MiB;
constexpr size_t WS_MSEL = WS_MISC + 9 * MiB;
constexpr size_t WS_KMEAN = WS_MISC + 10 * MiB;
constexpr size_t WS_END = 256 * MiB;
static_assert(W_END <= WS_H && WS_QB + (size_t)M * 768 * 2 <= WS_Y && WS_OCMP + (size_t)M * 512 * 4 <= WS_MISC, "ws map");

constexpr int NWAVES = 8, NTHREADS = 512;
constexpr int LDS_BYTES = 147456;
constexpr int RING_BYTES = 131072;
constexpr int MISC_OFF = RING_BYTES + 320;

namespace pg8 {
constexpr int BM = 256, BK = 64, HALF = 128, HTB = HALF * BK * 2, STAGE_BYTES = 8 * HTB, NXCD = 8, WGM = 8;
__host__ __device__ __forceinline__ int lds_byte(int r, int c) { const int st = (r >> 4) * 2 + (c >> 5), rr = r & 15, cc = c & 31, ob = rr * 64 + cc * 2; return st * 1024 + (ob ^ (((ob >> 9) & 1) << 5)); }
__host__ __device__ __forceinline__ void stage_rc(int b, int& R, int& C) { const int st = b / 1024, sb = b % 1024, swz = sb ^ (((sb >> 9) & 1) << 5); R = (st >> 1) * 16 + swz / 64; C = (st & 1) * 32 + (swz % 64) / 2; }
__host__ __device__ __forceinline__ int perm32(int rho) { const int n = rho >> 4, i = rho & 15; return 8 * (i >> 2) + 4 * n + (i & 3); }

struct Unit { int pm, pn; };
struct Gemm { const u16* A; const u16* Bt; int M, N, K, lda; };

struct StaticOrder {
    int nM, nN, nwg, G, c;
    __host__ __device__ void init(int M_, int N_, int G_, int c_) { nM = M_ / BM; nN = N_ / BM; nwg = nM * nN; G = G_; c = c_; }
    __host__ __device__ bool next(int i, Unit& u) const {
        const long L = (long)i * G + c; if (L >= nwg) return false;
        int wgid = (int)L; { const int q = nwg / NXCD, r = nwg % NXCD, xcd = wgid % NXCD, off = wgid / NXCD; wgid = (xcd < r ? xcd * (q + 1) : r * (q + 1) + (xcd - r) * q) + off; }
        const int nig = WGM * nN, gid = wgid / nig, fm = gid * WGM, gsz = (nM - fm) < WGM ? (nM - fm) : WGM;
        u.pm = fm + ((wgid % nig) % gsz); u.pn = (wgid % nig) / gsz; return true;
    }
    __device__ __forceinline__ void a_ready(const Unit&) const {}
    __device__ __forceinline__ void done(const Unit&) const {}
};

__device__ __forceinline__ unsigned pk_f16(float lo, float hi) { f16x2 v = {(f16)lo, (f16)hi}; return __builtin_bit_cast(unsigned, v); }

struct EpiF16 {
    static constexpr bool PERM = true;
    u16* O; int ldc;
    __device__ __forceinline__ void operator()(const f32x4 (&acc)[2][2][4][2], const Unit& u, int wr, int wc, int fr, int fq) const {
        const int row0 = u.pm * BM + wr * 64 + fr, col0 = u.pn * BM + wc * 32 + 8 * fq;
#pragma unroll
        for (int ai = 0; ai < 2; ++ai)
#pragma unroll
            for (int m = 0; m < 4; ++m) { u16* rowp = O + (size_t)(row0 + ai * HALF + m * 16) * ldc + col0;
#pragma unroll
                for (int bj = 0; bj < 2; ++bj) { const f32x4 v0 = acc[ai][bj][m][0], v1 = acc[ai][bj][m][1];
                    u32x4 w; w.x = pk_f16(v0[0], v0[1]); w.y = pk_f16(v0[2], v0[3]); w.z = pk_f16(v1[0], v1[1]); w.w = pk_f16(v1[2], v1[3]);
                    *(u32x4*)(rowp + bj * HALF) = w; } }
    }
};
__device__ __forceinline__ float silu_mul(float g, float u) { return g * u * __builtin_amdgcn_rcpf(1.0f + __builtin_amdgcn_exp2f(-g * LOG2E)); }
struct EpiSwiglu {
    static constexpr bool PERM = true;
    u16* O; int ldc;
    __device__ __forceinline__ void operator()(const f32x4 (&acc)[2][2][4][2], const Unit& u, int wr, int wc, int fr, int fq) const {
        const int row0 = u.pm * BM + wr * 64 + fr, col0 = u.pn * HALF + wc * 32 + 8 * fq;
#pragma unroll
        for (int ai = 0; ai < 2; ++ai)
#pragma unroll
            for (int m = 0; m < 4; ++m) { u16* rowp = O + (size_t)(row0 + ai * HALF + m * 16) * ldc + col0;
                const f32x4 g0 = acc[ai][0][m][0], g1 = acc[ai][0][m][1], u0 = acc[ai][1][m][0], u1 = acc[ai][1][m][1];
                u32x4 w; w.x = pk_f16(silu_mul(g0[0], u0[0]), silu_mul(g0[1], u0[1])); w.y = pk_f16(silu_mul(g0[2], u0[2]), silu_mul(g0[3], u0[3]));
                w.z = pk_f16(silu_mul(g1[0], u1[0]), silu_mul(g1[1], u1[1])); w.w = pk_f16(silu_mul(g1[2], u1[2]), silu_mul(g1[3], u1[3]));
                *(u32x4*)rowp = w; }
    }
};
struct EpiF32 {
    static constexpr bool PERM = false;
    float* C; int ldc;
    __device__ __forceinline__ void operator()(const f32x4 (&acc)[2][2][4][2], const Unit& u, int wr, int wc, int fr, int fq) const {
        const int row0 = u.pm * BM + wr * 64 + fr, col0 = u.pn * BM + wc * 32 + 4 * fq;
#pragma unroll
        for (int ai = 0; ai < 2; ++ai)
#pragma unroll
            for (int m = 0; m < 4; ++m) { float* rowp = C + (size_t)(row0 + ai * HALF + m * 16) * ldc + col0;
#pragma unroll
                for (int bj = 0; bj < 2; ++bj)
#pragma unroll
                    for (int n = 0; n < 2; ++n) *(f32x4*)(rowp + bj * HALF + n * 16) = acc[ai][bj][m][n]; }
    }
};

template <class Epi, class Sched, bool ALIGN_EPI>
__device__ __forceinline__ void gemm_phase(LAS unsigned char* lds, const Gemm g, const Sched& S, const Epi& E) {
    const int tid = threadIdx.x, wid = __builtin_amdgcn_readfirstlane(tid >> 6), lane = tid & 63, wr = wid >> 2, wc = wid & 3, fr = lane & 15, fq = lane >> 4;
    const int K = g.K, nt = K / BK, lda = g.lda;
    unsigned voffA[2], voffB[2];
#pragma unroll
    for (int i = 0; i < 2; ++i) { int R, C; stage_rc(tid * 16 + i * 8192, R, C); const int Rb = Epi::PERM ? ((R & ~31) + perm32(R & 31)) : R;
        voffA[i] = (unsigned)(R * lda + C) * 2u; voffB[i] = (unsigned)(Rb * K + C) * 2u; }
    const size_t kstep = (size_t)(BK * 2);
    const size_t hstepA = (size_t)HALF * lda * 2, hstepB = (size_t)HALF * K * 2;
    const size_t tstepA = 2 * hstepA, tstepB = 2 * hstepB;
    const unsigned ldsw = (unsigned)wid * 1024u;
    const int aoff = lds_byte(wr * 64 + fr, fq * 8), boff = lds_byte(wc * 32 + fr, fq * 8);
#define PG8_SA(b, h) (((b) * 2 + (h)) * HTB)
#define PG8_SB(b, h) ((4 + (b) * 2 + (h)) * HTB)
#define PG8_STAGE(bufoff, gbase, voff) do { _Pragma("unroll") for (int _i = 0; _i < 2; ++_i) \
        __builtin_amdgcn_global_load_lds((const unsigned*)((const char*)(gbase) + (voff)[_i]), (LAS unsigned*)(lds + (bufoff) + ldsw + _i * 8192), 16, 0, 0); } while (0)
#define PG8_LDA(dst, b, h) do { _Pragma("unroll") for (int m = 0; m < 4; ++m) _Pragma("unroll") for (int k = 0; k < 2; ++k) dst[m][k] = *(const LAS f16x8*)(lds + PG8_SA(b, h) + aoff + m * 2048 + k * 1024); } while (0)
#define PG8_LDB(dst, b, h) do { _Pragma("unroll") for (int n = 0; n < 2; ++n) _Pragma("unroll") for (int k = 0; k < 2; ++k) dst[n][k] = *(const LAS f16x8*)(lds + PG8_SB(b, h) + boff + n * 2048 + k * 1024); } while (0)
#define PG8_MMA(ai, bj, At, Bt) do { __builtin_amdgcn_s_setprio(1); _Pragma("unroll") for (int m = 0; m < 4; ++m) _Pragma("unroll") for (int n = 0; n < 2; ++n) _Pragma("unroll") for (int k = 0; k < 2; ++k) \
        acc[ai][bj][m][n] = __builtin_amdgcn_mfma_f32_16x16x32_f16(Bt[n][k], At[m][k], acc[ai][bj][m][n], 0, 0, 0); __builtin_amdgcn_s_setprio(0); } while (0)
#define PG8_WAIT_V(n) asm volatile("s_waitcnt vmcnt(" #n ")" ::: "memory")
#define PG8_WAIT_L(n) asm volatile("s_waitcnt lgkmcnt(" #n ")" ::: "memory")
#define PG8_BAR __builtin_amdgcn_s_barrier()
#define PG8_SCHED __builtin_amdgcn_sched_barrier(0)
    Unit cur, nxt; int ui = 0;
    if (!S.next(0, cur)) return;
    f32x4 acc[2][2][4][2];
#pragma unroll
    for (int a = 0; a < 2; ++a)
#pragma unroll
        for (int b = 0; b < 2; ++b)
#pragma unroll
            for (int m = 0; m < 4; ++m)
#pragma unroll
                for (int n = 0; n < 2; ++n) acc[a][b][m][n] = (f32x4){0.f, 0.f, 0.f, 0.f};
    f16x8 At[4][2], B0[2][2], B1[2][2];
    const char* cA = (const char*)g.A + (size_t)cur.pm * tstepA; const char* cB = (const char*)g.Bt + (size_t)cur.pn * tstepB;
    S.a_ready(cur);
    PG8_STAGE(PG8_SB(0, 0), cB, voffB); PG8_STAGE(PG8_SB(0, 1), cB + hstepB, voffB); PG8_STAGE(PG8_SA(0, 0), cA, voffA); PG8_STAGE(PG8_SA(0, 1), cA + hstepA, voffA);
    if (wr == 1) PG8_BAR;
    PG8_WAIT_V(2); PG8_BAR;
    PG8_STAGE(PG8_SB(1, 0), cB + kstep, voffB); PG8_STAGE(PG8_SA(1, 0), cA + kstep, voffA); PG8_STAGE(PG8_SB(1, 1), cB + hstepB + kstep, voffB);
    PG8_WAIT_V(6); PG8_BAR;
    for (;;) {
        const bool has_next = S.next(ui + 1, nxt);
        const char* nA = has_next ? (const char*)g.A + (size_t)nxt.pm * tstepA : cA; const char* nB = has_next ? (const char*)g.Bt + (size_t)nxt.pn * tstepB : cB;
        for (int t = 0; t < nt; t += 2) {
            const bool last = (t == nt - 2);
            const char* a1 = cA + (size_t)(t + 1) * kstep;
            const char* a2 = last ? nA : cA + (size_t)(t + 2) * kstep; const char* b2 = last ? nB : cB + (size_t)(t + 2) * kstep;
            const char* a3 = a2 + kstep; const char* b3 = b2 + kstep;
            if (last && has_next) S.a_ready(nxt);
            PG8_LDB(B0, 0, 0); PG8_LDB(B1, 0, 1); PG8_SCHED; PG8_LDA(At, 0, 0); PG8_STAGE(PG8_SA(1, 1), a1 + hstepA, voffA);
            PG8_WAIT_V(8); PG8_WAIT_L(0); PG8_BAR; PG8_MMA(0, 0, At, B0); PG8_MMA(0, 1, At, B1); PG8_BAR; PG8_SCHED;
            PG8_LDA(At, 0, 1); PG8_STAGE(PG8_SB(0, 0), b2, voffB); PG8_STAGE(PG8_SB(0, 1), b2 + hstepB, voffB); PG8_STAGE(PG8_SA(0, 0), a2, voffA);
            PG8_WAIT_V(8); PG8_WAIT_L(0); PG8_BAR; PG8_MMA(1, 0, At, B0); PG8_MMA(1, 1, At, B1); PG8_BAR; PG8_SCHED;
            PG8_LDB(B0, 1, 0); PG8_LDB(B1, 1, 1); PG8_SCHED; PG8_LDA(At, 1, 0); PG8_STAGE(PG8_SA(0, 1), a2 + hstepA, voffA);
            PG8_WAIT_V(8); PG8_WAIT_L(0); PG8_BAR; PG8_MMA(0, 0, At, B0); PG8_MMA(0, 1, At, B1); PG8_BAR; PG8_SCHED;
            PG8_LDA(At, 1, 1); PG8_STAGE(PG8_SB(1, 0), b3, voffB); PG8_STAGE(PG8_SB(1, 1), b3 + hstepB, voffB); PG8_STAGE(PG8_SA(1, 0), a3, voffA);
            PG8_WAIT_V(8); PG8_WAIT_L(0); PG8_BAR; PG8_MMA(1, 0, At, B0); PG8_MMA(1, 1, At, B1); PG8_BAR; PG8_SCHED;
        }
        if constexpr (ALIGN_EPI) { if (wr == 0) PG8_BAR; }
        E(acc, cur, wr, wc, fr, fq); S.done(cur);
        if (!has_next) break;
#pragma unroll
        for (int a = 0; a < 2; ++a)
#pragma unroll
            for (int b = 0; b < 2; ++b)
#pragma unroll
                for (int m = 0; m < 4; ++m)
#pragma unroll
                    for (int n = 0; n < 2; ++n) acc[a][b][m][n] = (f32x4){0.f, 0.f, 0.f, 0.f};
        cur = nxt; cA = nA; cB = nB; ++ui;
        if constexpr (ALIGN_EPI) { if (wr == 1) PG8_BAR; }
    }
    PG8_WAIT_V(0);
    if constexpr (!ALIGN_EPI) { if (wr == 0) PG8_BAR; }
    PG8_BAR;
#undef PG8_SA
#undef PG8_SB
#undef PG8_STAGE
#undef PG8_LDA
#undef PG8_LDB
#undef PG8_MMA
#undef PG8_WAIT_V
#undef PG8_WAIT_L
#undef PG8_BAR
#undef PG8_SCHED
}
}

#define XB_TMO      128
#define XB_XCNT(j)  (256  + 64 * (j))
#define XB_XSUB(j)  (1280 + 64 * (j))
#define XB_XGEN(j)  (2304 + 64 * (j))
#define XB_TOP      3328
#define XB_TOPGEN   3392
#define XCD_BAR_WORDS 3456
#define XB_SPIN_CAP (1u << 23)
__device__ __forceinline__ unsigned xb_ld(unsigned* p)              { return __hip_atomic_load(p, __ATOMIC_RELAXED, __HIP_MEMORY_SCOPE_AGENT); }
__device__ __forceinline__ unsigned xb_add(unsigned* p, unsigned v) { return __hip_atomic_fetch_add(p, v, __ATOMIC_RELAXED, __HIP_MEMORY_SCOPE_AGENT); }
__device__ __forceinline__ unsigned xb_xcc_id() { return (unsigned)__builtin_amdgcn_s_getreg((3 << 11) | 20) & 0xFu; }
#define XB_SPIN(cond, bar) do { unsigned _sp = 0; while (cond) { __builtin_amdgcn_s_sleep(1); \
    if ((++_sp & 255u) == 0u) { if (xb_ld(&(bar)[XB_TMO])) break; if (_sp > XB_SPIN_CAP) { atomicAdd(&(bar)[XB_TMO], 1u); break; } } } } while (0)
struct XcdBarrier { unsigned* bar; unsigned x; volatile LAS unsigned* st; };
__device__ __forceinline__ XcdBarrier xcd_barrier_post(unsigned* bar, volatile LAS unsigned* st) {
    XcdBarrier b; b.bar = bar; b.x = xb_xcc_id(); b.st = st;
    if (threadIdx.x == 0) (void)xb_add(&bar[XB_XCNT(b.x)], 1u);
    return b;
}
__device__ __forceinline__ void xcd_barrier_complete(unsigned* bar, unsigned x, unsigned& nloc, unsigned& nx) {
    const unsigned G = gridDim.x * gridDim.y * gridDim.z;
    unsigned sum, cnt, mine, sp = 0u;
    for (;;) {
        sum = 0u; cnt = 0u; mine = 0u;
#pragma unroll
        for (unsigned j = 0; j < 16; ++j) { const unsigned c = xb_ld(&bar[XB_XCNT(j)]); sum += c; cnt += (c > 0u) ? 1u : 0u; mine = (j == x) ? c : mine; }
        if (sum == G) break;
        __builtin_amdgcn_s_sleep(1);
        if ((++sp & 255u) == 0u) { if (xb_ld(&bar[XB_TMO])) break; if (sp > XB_SPIN_CAP) { atomicAdd(&bar[XB_TMO], 1u); break; } }
    }
    nloc = mine > 0u ? mine : 1u; nx = cnt > 0u ? cnt : 1u;
}
__device__ __forceinline__ void xcd_barrier(const XcdBarrier& b) {
    asm volatile("s_waitcnt vmcnt(0)" ::: "memory");
    __syncthreads();
    if (threadIdx.x == 0) {
        unsigned* bar = b.bar;
        __builtin_amdgcn_s_waitcnt(0);
        unsigned nloc = b.st[0], nx = b.st[1];
        if (nloc == 0u) { xcd_barrier_complete(bar, b.x, nloc, nx); b.st[0] = nloc; b.st[1] = nx; }
        const unsigned old = xb_add(&bar[XB_XSUB(b.x)], 1u);
        const unsigned gen = old / nloc;
        if (old + 1u == (gen + 1u) * nloc) {
            __builtin_amdgcn_fence(__ATOMIC_RELEASE, "agent");
            asm volatile("s_waitcnt vmcnt(0)" ::: "memory");
            const unsigned og = xb_add(&bar[XB_TOP], 1u);
            const unsigned tg = og / nx;
            if (og + 1u == (tg + 1u) * nx) xb_add(&bar[XB_TOPGEN], 1u);
            else XB_SPIN(xb_ld(&bar[XB_TOPGEN]) == tg, bar);
            __builtin_amdgcn_fence(__ATOMIC_ACQUIRE, "agent");
            xb_add(&bar[XB_XGEN(b.x)], 1u);
            asm volatile("s_waitcnt vmcnt(0)" ::: "memory");
        } else {
            XB_SPIN(xb_ld(&bar[XB_XGEN(b.x)]) == gen, bar);
            __builtin_amdgcn_fence(__ATOMIC_ACQUIRE, "agent");
            asm volatile("s_waitcnt vmcnt(0)" ::: "memory");
        }
    }
    __syncthreads();
}

__device__ __forceinline__ float wave_sum(float v) {
#pragma unroll
    for (int o = 1; o < 64; o <<= 1) v += __shfl_xor(v, o);
    return v;
}
__device__ __forceinline__ int t5_bucket(int n) {
    if (n < 16) return n;
    int b = 16;
    b += (n >= 21); b += (n >= 27); b += (n >= 35); b += (n >= 46); b += (n >= 59); b += (n >= 77); b += (n >= 99); b += (n >= 128);
    b += (n >= 166); b += (n >= 216); b += (n >= 280); b += (n >= 363); b += (n >= 470); b += (n >= 609); b += (n >= 790);
    return b;
}

__device__ __forceinline__ int conv_row(int mode, int n) {
    if (mode == 1) return 256 * (n >> 7) + (n & 127);
    if (mode == 2) return 256 * (n >> 7) + 128 + (n & 127);
    if (mode == 4) return n < 1280 ? n : (n < 1304 ? 2816 + (n - 1280) : n - 24);
    return n;
}
__device__ __forceinline__ float conv_scale(int mode, int n) {
    if (mode == 3) return n < 512 ? QS : 1.0f;
    if (mode == 4) return (n < 512 || (n >= 1304 && n < 1816)) ? QS : 1.0f;
    if (mode == 5) return QS96;
    return 1.0f;
}
__device__ __forceinline__ void conv_matrix(const float* W, int K, int N, u16* WT, int ldk, int mode, LAS float* scr, int gw, int NGW, int lane) {
    const int nblk = (N + 31) / 32, nitems = (K / 64) * nblk;
    for (int item = gw; item < nitems; item += NGW) {
        const int kb = item / nblk, nb = item % nblk, k0 = 64 * kb, n0 = 32 * nb;
        const int nl = n0 + (lane & 31);
#pragma unroll 8
        for (int i = 0; i < 32; ++i) { const int kk = 2 * i + (lane >> 5); scr[kk * 33 + (lane & 31)] = (nl < N) ? W[(size_t)(k0 + kk) * N + nl] : 0.f; }
        asm volatile("s_waitcnt lgkmcnt(0)" ::: "memory");
        const int c = lane & 7;
#pragma unroll
        for (int j = 0; j < 4; ++j) { const int n = (lane >> 3) + 8 * j; const LAS float* s = scr + (8 * c) * 33 + n;
            if (n0 + n < N) { const float sc = conv_scale(mode, n0 + n);
                u32x4 o; o.x = pg8::pk_f16(s[0 * 33] * sc, s[1 * 33] * sc); o.y = pg8::pk_f16(s[2 * 33] * sc, s[3 * 33] * sc); o.z = pg8::pk_f16(s[4 * 33] * sc, s[5 * 33] * sc); o.w = pg8::pk_f16(s[6 * 33] * sc, s[7 * 33] * sc);
                *(u32x4*)(WT + (size_t)conv_row(mode, n0 + n) * ldk + k0 + 8 * c) = o; } }
        asm volatile("s_waitcnt lgkmcnt(0)" ::: "memory");
    }
}
__device__ __forceinline__ void zero_u32x4(void* p, size_t n16, int gtid, int NT) { for (size_t i = gtid; i < n16; i += NT) ((u32x4*)p)[i] = (u32x4){0u, 0u, 0u, 0u}; }

template <bool HASY, bool HASH>
__device__ __forceinline__ void norm_rows(const float* Xin, const float* Y, const float* post, float w, float* Xout, const float* pre, u16* H, int gw, int NGW, int lane) {
    for (int m = gw; m < M; m += NGW) {
        const f32x4* xr = (const f32x4*)(Xin + (size_t)m * DM) + lane;
        f32x4 x[4];
#pragma unroll
        for (int j = 0; j < 4; ++j) x[j] = xr[64 * j];
        if (HASY) {
            const f32x4* yr = (const f32x4*)(Y + (size_t)m * DM) + lane; f32x4 y[4]; float ss = 0.f;
#pragma unroll
            for (int j = 0; j < 4; ++j) { y[j] = yr[64 * j]; ss += (y[j].x * y[j].x + y[j].y * y[j].y) + (y[j].z * y[j].z + y[j].w * y[j].w); }
            const float rstd = 1.0f / sqrtf(wave_sum(ss) * (1.0f / DM) + EPS) * w;
#pragma unroll
            for (int j = 0; j < 4; ++j) { const f32x4 pg = ((const f32x4*)post)[lane + 64 * j]; x[j] = x[j] + y[j] * rstd * pg; }
        }
        f32x4* xo = (f32x4*)(Xout + (size_t)m * DM) + lane;
#pragma unroll
        for (int j = 0; j < 4; ++j) xo[64 * j] = x[j];
        if (HASH) {
            float ss = 0.f;
#pragma unroll
            for (int j = 0; j < 4; ++j) ss += (x[j].x * x[j].x + x[j].y * x[j].y) + (x[j].z * x[j].z + x[j].w * x[j].w);
            const float rstd = 1.0f / sqrtf(wave_sum(ss) * (1.0f / DM) + EPS);
            u32x2* ho = (u32x2*)(H + (size_t)m * DM) + lane;
#pragma unroll
            for (int j = 0; j < 4; ++j) { const f32x4 pg = ((const f32x4*)pre)[lane + 64 * j]; const f32x4 h = x[j] * rstd * pg;
                u32x2 o; o.x = pg8::pk_f16(h.x, h.y); o.y = pg8::pk_f16(h.z, h.w); ho[64 * j] = o; }
        }
    }
}

__device__ __forceinline__ void mla_prep(const u16* Z0, const float* qn, const float* kvn, const f32x2* rope, u16* CQN, u16* CKVN, u16* KRb, int gw, int NGW, int lane) {
    for (int m = gw; m < M; m += NGW) {
        const f16* z = (const f16*)Z0 + (size_t)m * N0;
        { const f16x4 c = *(const f16x4*)(z + Z0_CQ + 4 * lane); const float c0 = (float)c[0], c1 = (float)c[1], c2 = (float)c[2], c3 = (float)c[3];
          const float rstd = 1.0f / sqrtf(wave_sum((c0 * c0 + c1 * c1) + (c2 * c2 + c3 * c3)) * (1.0f / 256.f) + EPS);
          const f32x4 g = ((const f32x4*)qn)[lane];
          u32x2 o; o.x = pg8::pk_f16(c0 * rstd * g.x, c1 * rstd * g.y); o.y = pg8::pk_f16(c2 * rstd * g.z, c3 * rstd * g.w);
          *((u32x2*)(CQN + (size_t)m * 256) + lane) = o; }
        { const f16x2 c = *(const f16x2*)(z + Z0_CKV + 2 * lane); const float c0 = (float)c[0], c1 = (float)c[1];
          const float rstd = 1.0f / sqrtf(wave_sum(c0 * c0 + c1 * c1) * (1.0f / 128.f) + EPS);
          const f32x2 g = ((const f32x2*)kvn)[lane];
          unsigned* o = (unsigned*)(CKVN + (size_t)m * 256);
          o[lane] = pg8::pk_f16(c0 * rstd * g.x, c1 * rstd * g.y); o[64 + lane] = 0u; }
        if (lane < 16) { const float x1 = (float)z[Z0_KR + lane], x2 = (float)z[Z0_KR + 16 + lane]; const f32x2 cs = rope[(m & (SEQ - 1)) * 16 + lane];
          f16* o = (f16*)KRb + (size_t)m * 32; o[lane] = (f16)(x1 * cs.x - x2 * cs.y); o[16 + lane] = (f16)(x2 * cs.x + x1 * cs.y); }
    }
}

template <int DQK, class KeyFn, class ScoreFn>
__device__ __forceinline__ void naive_attend(const float (&q)[DQK], float& m, float& l, float (&o)[64], int klo, int khi, const KeyFn& kf, const ScoreFn& sf) {
    for (int kp = klo; kp <= khi; ++kp) {
        const f16x8* kr = (const f16x8*)kf.k(kp);
        float s = 0.f;
#pragma unroll
        for (int c = 0; c < 8; ++c) { const f16x8 kv = kr[c];
#pragma unroll
            for (int j = 0; j < 8; ++j) s += q[c * 8 + j] * (float)kv[j]; }
        if constexpr (DQK == 96) { const f16x8* k2 = (const f16x8*)kf.k2(kp);
#pragma unroll
            for (int c = 0; c < 4; ++c) { const f16x8 kv = k2[c];
#pragma unroll
                for (int j = 0; j < 8; ++j) s += q[64 + c * 8 + j] * (float)kv[j]; } }
        if (sf(kp, s)) {
            const float mn = fmaxf(m, s), a = __builtin_amdgcn_exp2f(m - mn), p = __builtin_amdgcn_exp2f(s - mn);
            m = mn; l = l * a + p;
            const f16x8* vr = (const f16x8*)kf.v(kp);
#pragma unroll
            for (int c = 0; c < 8; ++c) { const f16x8 vv = vr[c];
#pragma unroll
                for (int j = 0; j < 8; ++j) o[c * 8 + j] = o[c * 8 + j] * a + p * (float)vv[j]; }
        }
    }
}
struct KeyZ { const f16* kbase; const f16* vbase; int pitch;
    __device__ __forceinline__ const f16* k(int kp) const { return kbase + (size_t)kp * pitch; }
    __device__ __forceinline__ const f16* k2(int) const { return nullptr; }
    __device__ __forceinline__ const f16* v(int kp) const { return vbase + (size_t)kp * pitch; } };
struct KeyMLA { const f16* kvb; const f16* kr;
    __device__ __forceinline__ const f16* k(int kp) const { return kvb + (size_t)kp * 1024; }
    __device__ __forceinline__ const f16* k2(int kp) const { return kr + (size_t)kp * 32; }
    __device__ __forceinline__ const f16* v(int kp) const { return kvb + (size_t)kp * 1024 + 64; } };

__device__ __forceinline__ void store_o64(u16* dst, const float (&o)[64], float sc) {
#pragma unroll
    for (int c = 0; c < 8; ++c) { u32x4 w; w.x = pg8::pk_f16(o[c * 8 + 0] * sc, o[c * 8 + 1] * sc); w.y = pg8::pk_f16(o[c * 8 + 2] * sc, o[c * 8 + 3] * sc);
        w.z = pg8::pk_f16(o[c * 8 + 4] * sc, o[c * 8 + 5] * sc); w.w = pg8::pk_f16(o[c * 8 + 6] * sc, o[c * 8 + 7] * sc); ((u32x4*)dst)[c] = w; }
}
template <int N> __device__ __forceinline__ void load_q(float (&q)[N], const f16* src, int off, int cnt8) {
#pragma unroll
    for (int c = 0; c < cnt8; ++c) { const f16x8 v = ((const f16x8*)src)[c];
#pragma unroll
        for (int j = 0; j < 8; ++j) q[off + c * 8 + j] = (float)v[j]; }
}

__device__ __forceinline__ void l0_attn_naive(const u16* Z0, const u16* QBp, const u16* KVBp, const u16* KRp, const float* bias, const f32x2* rope, const float* sinks, u16* O, int wave, int lane) {
    for (int tb = blockIdx.x; tb < M / 64; tb += gridDim.x) {
        const int token = tb * 64 + lane, b = token / SEQ, qpos = token % SEQ, qmin = (tb * 64) % SEQ, head = wave, hkv = head >> 2;
        {
            float q[64], o[64];
            load_q<64>(q, (const f16*)Z0 + (size_t)token * N0 + Z0_QA + head * 64, 0, 8);
#pragma unroll
            for (int d = 0; d < 64; ++d) o[d] = 0.f;
            float m = sinks[head] * LOG2E, l = 1.f;
            const KeyZ kf{(const f16*)Z0 + (size_t)b * SEQ * N0 + Z0_KA + hkv * 64, (const f16*)Z0 + (size_t)b * SEQ * N0 + Z0_VA + hkv * 64, N0};
            const float* bt = bias + (0 + head) * 2048;
            auto sf = [&](int kp, float& s) -> bool { const int d = qpos - kp; if (d < 0 || d >= 128) return false; s += bt[d]; return true; };
            const int klo = qmin - 127 < 0 ? 0 : qmin - 127;
            naive_attend<64>(q, m, l, o, klo, qmin + 63, kf, sf);
            store_o64(O + (size_t)token * DM + head * 64, o, 1.0f / l);
        }
        {
            float q[96], o[64];
            load_q<96>(q, (const f16*)QBp + (size_t)token * 768 + head * 96, 0, 12);
#pragma unroll
            for (int i = 0; i < 16; ++i) { const f32x2 cs = rope[qpos * 16 + i]; const float x1 = q[64 + i], x2 = q[80 + i]; q[64 + i] = x1 * cs.x - x2 * cs.y; q[80 + i] = x2 * cs.x + x1 * cs.y; }
#pragma unroll
            for (int d = 0; d < 64; ++d) o[d] = 0.f;
            float m = NEG, l = 0.f;
            const KeyMLA kf{(const f16*)KVBp + (size_t)b * SEQ * 1024 + head * 128, (const f16*)KRp + (size_t)b * SEQ * 32};
            auto sf = [&](int kp, float&) -> bool { return kp <= qpos; };
            naive_attend<96>(q, m, l, o, 0, qmin + 63, kf, sf);
            store_o64(O + (size_t)token * DM + 512 + head * 64, o, 1.0f / l);
        }
    }
}

__device__ __forceinline__ void l1_compress_hidden(const u16* Z1, const float* pe_k, const float* pe_v, const float* wk1, const float* wv1, float* HID, float* KMEAN, int gw, int NGW, int lane) {
    const int nitems = 2 * BATCH * NCMP * 2 * 4;
    for (int it = gw; it < nitems; it += NGW) {
        const int nb = it & 3, row = (it >> 2) % (BATCH * NCMP * 2), sel = (it >> 2) / (BATCH * NCMP * 2);
        const int hkv = row & 1, c = (row >> 1) % NCMP, b = (row >> 1) / NCMP, n = nb * 64 + lane;
        const f16* x = (const f16*)Z1 + ((size_t)b * SEQ + 16 * c) * N1 + (sel ? Z1_VC : Z1_KC) + hkv * 64;
        const float* pe = sel ? pe_v : pe_k; const float* w1 = sel ? wv1 : wk1;
        float acc = 0.f;
        for (int i = 0; i < 32; ++i) {
            const f16* xr = x + (size_t)i * N1;
#pragma unroll 8
            for (int d = 0; d < 64; ++d) acc += ((float)xr[d] + pe[i * 64 + d]) * w1[(size_t)(i * 64 + d) * 256 + n];
        }
        HID[((size_t)sel * (BATCH * NCMP * 2) + row) * 256 + n] = acc / (1.0f + __expf(-acc));
    }
    for (int it = gw; it < BATCH * 8 * 8; it += NGW) {
        const int h = it & 7, nbk = (it >> 3) & 7, b = it >> 6;
        const f16* x = (const f16*)Z1 + ((size_t)b * SEQ + nbk * 256) * N1 + Z1_KD + h * 64 + lane;
        float s = 0.f;
        for (int t = 0; t < 256; ++t) s += (float)x[(size_t)t * N1];
        KMEAN[(size_t)it * 64 + lane] = s * (1.0f / 256.f);
    }
}
__device__ __forceinline__ void l1_compress_out(const float* HID, const float* wk2, const float* wv2, float* KCMP, float* VCMP, int gw, int NGW, int lane) {
    const int nrows = BATCH * NCMP * 2;
    for (int it = gw; it < 2 * nrows; it += NGW) {
        const int sel = it / nrows, row = it % nrows;
        const float* h = HID + ((size_t)sel * nrows + row) * 256; const float* w2 = sel ? wv2 : wk2;
        float acc = 0.f;
        for (int n = 0; n < 256; ++n) acc += h[n] * w2[n * 64 + lane];
        (sel ? VCMP : KCMP)[(size_t)row * 64 + lane] = acc;
    }
}
__device__ __forceinline__ void l1_cmp_attn(const u16* Z1, const float* KCMP, const float* VCMP, float* OCMP, float* IMP, int wave, int lane) {
    for (int tb = blockIdx.x; tb < M / 64; tb += gridDim.x) {
        const int token = tb * 64 + lane, b = token / SEQ, qpos = token % SEQ, qmin = (tb * 64) % SEQ, head = wave, hkv = head >> 2;
        float q[64], o[64];
        load_q<64>(q, (const f16*)Z1 + (size_t)token * N1 + Z1_QC + head * 64, 0, 8);
#pragma unroll
        for (int d = 0; d < 64; ++d) o[d] = 0.f;
        const int cmax = qpos >= 31 ? (qpos - 31) >> 4 : -1;
        const int cmaxw = (qmin + 63 - 31) >> 4;
        const float* kc = KCMP + ((size_t)b * NCMP * 2 + hkv) * 64; const float* vc = VCMP + ((size_t)b * NCMP * 2 + hkv) * 64;
        float m = NEG, l = 0.f;
        for (int c = 0; c <= cmaxw && c < NCMP; ++c) {
            const float* kr = kc + (size_t)c * 128; float s = 0.f;
#pragma unroll
            for (int d = 0; d < 64; ++d) s += q[d] * kr[d];
            if (c <= cmax) { const float mn = fmaxf(m, s), a = __builtin_amdgcn_exp2f(m - mn), p = __builtin_amdgcn_exp2f(s - mn); m = mn; l = l * a + p;
                const float* vr = vc + (size_t)c * 128;
#pragma unroll
                for (int d = 0; d < 64; ++d) o[d] = o[d] * a + p * vr[d]; }
        }
        const float inv = l > 0.f ? 1.0f / l : 0.f;
        float* op = OCMP + (size_t)token * 512 + head * 64;
#pragma unroll
        for (int d = 0; d < 64; d += 4) *(f32x4*)(op + d) = (f32x4){o[d] * inv, o[d + 1] * inv, o[d + 2] * inv, o[d + 3] * inv};
        float* ip = IMP + ((size_t)token * 8 + head) * 32;
        for (int j = 0; j < 32; ++j) {
            float acc = 0.f;
            if (4 * j - 1 <= cmaxw) {
#pragma unroll
                for (int cc = -1; cc < 4; ++cc) { const int c = 4 * j + cc;
                    if (c >= 0 && c < NCMP && c <= cmaxw) { const float* kr = kc + (size_t)c * 128; float s = 0.f;
#pragma unroll
                        for (int d = 0; d < 64; ++d) s += q[d] * kr[d];
                        if (c <= cmax) acc += __builtin_amdgcn_exp2f(s - m) * inv; } }
            }
            ip[j] = acc;
        }
    }
}
__device__ __forceinline__ void l1_select(const u16* Z1, const float* IMP, const float* KMEAN, unsigned* SEL, unsigned* MSEL, int gtid, int NT) {
    for (int r = gtid; r < M * 2; r += NT) {
        const int token = r >> 1, hkv = r & 1, qpos = token % SEQ, cur = qpos >> 6;
        float v[32];
#pragma unroll
        for (int j = 0; j < 32; ++j) v[j] = 0.f;
#pragma unroll
        for (int g = 0; g < 4; ++g) { const f32x4* ip = (const f32x4*)(IMP + ((size_t)token * 8 + hkv * 4 + g) * 32);
#pragma unroll
            for (int j4 = 0; j4 < 8; ++j4) { const f32x4 t = ip[j4]; v[4 * j4] += t.x; v[4 * j4 + 1] += t.y; v[4 * j4 + 2] += t.z; v[4 * j4 + 3] += t.w; } }
#pragma unroll
        for (int j = 0; j < 32; ++j) { const bool forced = (j == 0) || (j == cur) || (j == cur - 1); v[j] = forced ? 1e9f : (j <= cur ? v[j] : NEG); }
        unsigned mask = 0u;
#pragma unroll
        for (int r8 = 0; r8 < 8; ++r8) { float best = NEG; int bi = -1;
#pragma unroll
            for (int j = 0; j < 32; ++j) { const bool free_ = !((mask >> j) & 1u); if (free_ && v[j] > best) { best = v[j]; bi = j; } }
            if (bi >= 0) mask |= 1u << bi; }
        SEL[r] = mask;
    }
    for (int r = gtid; r < M * 8; r += NT) {
        const int token = r >> 3, h = r & 7, b = token / SEQ, qpos = token % SEQ, cur = qpos >> 8;
        float q[64];
        load_q<64>(q, (const f16*)Z1 + (size_t)token * N1 + Z1_QD + h * 64, 0, 8);
        float gte[8];
#pragma unroll
        for (int n = 0; n < 8; ++n) { gte[n] = NEG;
            if (n < cur) { const float* km = KMEAN + (((size_t)b * 8 + n) * 8 + h) * 64; float s = 0.f;
#pragma unroll
                for (int d = 0; d < 64; ++d) s += q[d] * km[d];
                gte[n] = s; } }
        unsigned mask = 0u;
#pragma unroll
        for (int r3 = 0; r3 < 3; ++r3) { float best = NEG; int bi = -1;
#pragma unroll
            for (int n = 0; n < 8; ++n) { const bool free_ = !((mask >> n) & 1u); if (free_ && gte[n] > best) { best = gte[n]; bi = n; } }
            if (bi >= 0) mask |= 1u << bi; }
        MSEL[r] = mask;
    }
}
__device__ __forceinline__ void l1_attn_naive(const u16* Z1, const float* bias, const unsigned* SEL, const unsigned* MSEL, float* OCMP, u16* O, int wave, int lane) {
    for (int tb = blockIdx.x; tb < M / 64; tb += gridDim.x) {
        const int token = tb * 64 + lane, b = token / SEQ, qpos = token % SEQ, qmin = (tb * 64) % SEQ, head = wave, hkv = head >> 2;
        const f16* zb = (const f16*)Z1 + (size_t)b * SEQ * N1;
        const f16* zt = (const f16*)Z1 + (size_t)token * N1;
        float q[64], o[64];
        load_q<64>(q, zt + Z1_QC + head * 64, 0, 8);
        const float* bt = bias + (8 + head) * 2048;
        float* oc = OCMP + (size_t)token * 512 + head * 64;
#pragma unroll
        for (int d = 0; d < 64; ++d) o[d] = 0.f;
        float m = NEG, l = 0.f;
        const unsigned sel = SEL[token * 2 + hkv];
        const KeyZ kf{zb + Z1_KS + hkv * 64, zb + Z1_VS + hkv * 64, N1};
        auto sf = [&](int kp, float& s) -> bool { const int d = qpos - kp; if (d < 0 || !((sel >> (kp >> 6)) & 1u)) return false; s += bt[d]; return true; };
        naive_attend<64>(q, m, l, o, 0, qmin + 63, kf, sf);
        const float g0 = 1.0f / (1.0f + __expf(-(float)zt[Z1_GL + head])), g1 = 1.0f / (1.0f + __expf(-(float)zt[Z1_GL + 8 + head]));
        const float inv = g1 / l;
#pragma unroll
        for (int d = 0; d < 64; d += 4) { f32x4 t = *(f32x4*)(oc + d); t = t * g0 + (f32x4){o[d] * inv, o[d + 1] * inv, o[d + 2] * inv, o[d + 3] * inv}; *(f32x4*)(oc + d) = t; }
    }
    for (int tb = blockIdx.x; tb < M / 64; tb += gridDim.x) {
        const int token = tb * 64 + lane, b = token / SEQ, qpos = token % SEQ, qmin = (tb * 64) % SEQ, head = wave, hkv = head >> 2;
        const f16* zb = (const f16*)Z1 + (size_t)b * SEQ * N1;
        const f16* zt = (const f16*)Z1 + (size_t)token * N1;
        float q[64], o[64];
        load_q<64>(q, zt + Z1_QC + head * 64, 0, 8);
        const float* bt = bias + (8 + head) * 2048;
        const float* oc = OCMP + (size_t)token * 512 + head * 64;
#pragma unroll
        for (int d = 0; d < 64; ++d) o[d] = 0.f;
        float m = NEG, l = 0.f;
        const KeyZ kf{zb + Z1_KW + hkv * 64, zb + Z1_VW + hkv * 64, N1};
        auto sf = [&](int kp, float& s) -> bool { const int d = qpos - kp; if (d < 0 || d >= 256) return false; s += bt[d]; return true; };
        const int klo = qmin - 255 < 0 ? 0 : qmin - 255;
        naive_attend<64>(q, m, l, o, klo, qmin + 63, kf, sf);
        const float g2 = 1.0f / (1.0f + __expf(-(float)zt[Z1_GL + 16 + head]));
        const float inv = g2 / l;
#pragma unroll
        for (int d = 0; d < 64; d += 4) { const f32x4 t = *(const f32x4*)(oc + d); o[d] = t.x + o[d] * inv; o[d + 1] = t.y + o[d + 1] * inv; o[d + 2] = t.z + o[d + 2] * inv; o[d + 3] = t.w + o[d + 3] * inv; }
        store_o64(O + (size_t)token * DM + head * 64, o, 1.0f);
    }
    for (int tb = blockIdx.x; tb < M / 64; tb += gridDim.x) {
        const int token = tb * 64 + lane, b = token / SEQ, qpos = token % SEQ, qmin = (tb * 64) % SEQ, head = wave;
        const f16* zb = (const f16*)Z1 + (size_t)b * SEQ * N1;
        const f16* zt = (const f16*)Z1 + (size_t)token * N1;
        float q[64], o[64];
        load_q<64>(q, zt + Z1_QD + head * 64, 0, 8);
#pragma unroll
        for (int d = 0; d < 64; ++d) o[d] = 0.f;
        float m = NEG, l = 0.f;
        const unsigned msel = MSEL[token * 8 + head]; const int cur = qpos >> 8;
        const float* bt = bias + (16 + head) * 2048;
        const KeyZ kf{zb + Z1_KD + head * 64, zb + Z1_VD + head * 64, N1};
        auto sf = [&](int kp, float& s) -> bool { const int d = qpos - kp; const int kb = kp >> 8; if (d < 0 || !(kb == cur || ((msel >> kb) & 1u))) return false; s += bt[d]; return true; };
        naive_attend<64>(q, m, l, o, 0, qmin + 63, kf, sf);
        store_o64(O + (size_t)token * DM + 512 + head * 64, o, 1.0f / l);
    }
}

namespace att {
typedef float f32x16 __attribute__((ext_vector_type(16)));
typedef short s16x4 __attribute__((ext_vector_type(4)));
enum { AT_A = 0, AT_B = 1, AT_SLC = 2, AT_WIN = 3, AT_D = 4 };
constexpr int PVB = 192;
constexpr int KB_OFF = 0, KB_STRIDE = 13312, VB_OFF = 26624, VB_STRIDE = 12288;
constexpr int BT_OFF = 51200, BT_PAD = 128, BT_HEAD = BT_PAD + 2048;
constexpr int RED_OFF = BT_OFF + 8 * BT_HEAD * 4;
static_assert(RED_OFF + 64 <= RING_BYTES, "attention LDS map");
constexpr float MINIT = -1e20f;

__device__ __forceinline__ void build_bias(LAS unsigned char* lds, const float* bias, int slot0, int tid) {
    LAS float* bt = (LAS float*)(lds + BT_OFF);
    for (int i = tid; i < 8 * BT_HEAD; i += NTHREADS) { const int h = i / BT_HEAD, d = i % BT_HEAD - BT_PAD; bt[i] = d >= 0 ? bias[(slot0 + h) * 2048 + d] : 0.f; }
}

struct TileRegs { u32x4 k0, k1, v; };
template <int DQK> __device__ __forceinline__ void tile_load(TileRegs& R, const f16* Kg, int kpitch, const f16* K2g, const f16* Vg, int vpitch, int t, int tid) {
    const int row = 64 * t + (tid >> 3), ch = tid & 7;
    R.k0 = *(const u32x4*)(Kg + (size_t)row * kpitch + ch * 8);
    if constexpr (DQK == 96) { if (tid < 256) R.k1 = *(const u32x4*)(K2g + (size_t)(64 * t + (tid >> 2)) * 32 + (tid & 3) * 8); }
    R.v = *(const u32x4*)(Vg + (size_t)row * vpitch + ch * 8);
}
template <int DQK> __device__ __forceinline__ void tile_store(const TileRegs& R, LAS unsigned char* kbuf, LAS unsigned char* vbuf, int tid) {
    constexpr int PK = DQK == 96 ? 208 : 144;
    const int row = tid >> 3, ch = tid & 7;
    *(LAS u32x4*)(kbuf + row * PK + ch * 16) = R.k0;
    if constexpr (DQK == 96) { if (tid < 256) *(LAS u32x4*)(kbuf + (tid >> 2) * PK + 128 + (tid & 3) * 16) = R.k1; }
    *(LAS u32x4*)(vbuf + row * PVB + ch * 16) = R.v;
}
__device__ __forceinline__ f16x8 tr_pair(const LAS unsigned char* p) {
    const s16x4 lo = __builtin_amdgcn_ds_read_tr16_b64_v4i16((LAS s16x4*)p);
    const s16x4 hi = __builtin_amdgcn_ds_read_tr16_b64_v4i16((LAS s16x4*)(p + 4 * PVB));
    typedef short s16x8 __attribute__((ext_vector_type(8)));
    const s16x8 v = __builtin_shufflevector(lo, hi, 0, 1, 2, 3, 4, 5, 6, 7);
    return __builtin_bit_cast(f16x8, v);
}

template <int MODE, int DQK>
__device__ __forceinline__ void attn_tiles(LAS unsigned char* lds, const f16* Kg, int kpitch, const f16* K2g, const f16* Vg, int vpitch,
        const f16x8 (&qf)[DQK / 16], int qpos, int wq_lo, unsigned tilemask, unsigned rowsel, int cur_blk, const LAS float* bt,
        float& m, float& l, f32x16 (&oacc)[2], int tid, int lane) {
    constexpr int PK = DQK == 96 ? 208 : 144;
    constexpr bool HAS_BIAS = MODE != AT_B;
    constexpr int W = MODE == AT_A ? 128 : (MODE == AT_WIN ? 256 : (1 << 30));
    if (!tilemask) return;
    const int hi = lane >> 5, r32 = lane & 31;
    const int pirow = (r32 & 19) | ((r32 & 4) << 1) | ((r32 & 8) >> 1);
    const int g4 = lane >> 4, lg = lane & 15;
    const unsigned kfoff = pirow * PK + hi * 16;
    const unsigned vfoff = (8 * (g4 >> 1) + (lg >> 2)) * PVB + (16 * (g4 & 1) + 4 * (lg & 3)) * 2;
    const int wq_hi = wq_lo + 31;
    unsigned rem = tilemask; int t = __builtin_ctz(rem); rem &= rem - 1;
    TileRegs R;
    tile_load<DQK>(R, Kg, kpitch, K2g, Vg, vpitch, t, tid);
    tile_store<DQK>(R, lds + KB_OFF, lds + VB_OFF, tid);
    __syncthreads();
    int cb = 0;
    for (;;) {
        int tn = -1;
        if (rem) { tn = __builtin_ctz(rem); rem &= rem - 1; tile_load<DQK>(R, Kg, kpitch, K2g, Vg, vpitch, tn, tid); }
        const int k0 = 64 * t;
        bool live = (k0 <= wq_hi) && (wq_lo - (k0 + 63) < W);
        bool rok = true;
        if constexpr (MODE == AT_SLC) rok = (rowsel >> t) & 1u;
        if constexpr (MODE == AT_D) rok = ((t >> 2) == cur_blk) || ((rowsel >> (t >> 2)) & 1u);
        if constexpr (MODE == AT_SLC || MODE == AT_D) live = live && (__builtin_amdgcn_ballot_w64(rok) != 0ull);
        if (live) {
            const LAS unsigned char* kb = lds + KB_OFF + cb * KB_STRIDE + kfoff;
            const LAS unsigned char* vb = lds + VB_OFF + cb * VB_STRIDE + vfoff;
            f32x16 p0, p1;
#pragma unroll
            for (int r = 0; r < 16; ++r) { p0[r] = 0.f; p1[r] = 0.f; }
#pragma unroll
            for (int d0 = 0; d0 < DQK / 16; ++d0) {
                const f16x8 ka = *(const LAS f16x8*)(kb + d0 * 32);
                const f16x8 kc = *(const LAS f16x8*)(kb + 32 * PK + d0 * 32);
                p0 = __builtin_amdgcn_mfma_f32_32x32x16_f16(ka, qf[d0], p0, 0, 0, 0);
                p1 = __builtin_amdgcn_mfma_f32_32x32x16_f16(kc, qf[d0], p1, 0, 0, 0);
            }
            const int dq = qpos - k0 - 8 * hi;
            if constexpr (HAS_BIAS) {
                const LAS float* bp = bt + (dq - 55);
#pragma unroll
                for (int r = 0; r < 16; ++r) { p0[r] += bp[55 - (16 * (r >> 3) + (r & 7))]; p1[r] += bp[55 - (32 + 16 * (r >> 3) + (r & 7))]; }
            }
            const bool emask = (k0 + 63 > wq_lo) || (wq_hi - k0 >= W);
            if (emask) {
#pragma unroll
                for (int r = 0; r < 16; ++r) { const int d0_ = dq - (16 * (r >> 3) + (r & 7)), d1_ = d0_ - 32;
                    p0[r] = (d0_ >= 0 && d0_ < W) ? p0[r] : NEG; p1[r] = (d1_ >= 0 && d1_ < W) ? p1[r] : NEG; }
            }
            if constexpr (MODE == AT_SLC || MODE == AT_D) {
                if (!rok) {
#pragma unroll
                    for (int r = 0; r < 16; ++r) { p0[r] = NEG; p1[r] = NEG; } }
            }
            float mx = fmaxf(p0[0], p1[0]);
#pragma unroll
            for (int r = 1; r < 16; ++r) mx = fmaxf(mx, fmaxf(p0[r], p1[r]));
            mx = fmaxf(mx, __shfl_xor(mx, 32));
            const float mn = fmaxf(m, mx), alpha = __builtin_amdgcn_exp2f(m - mn);
            m = mn;
            float ps = 0.f;
#pragma unroll
            for (int r = 0; r < 16; ++r) { p0[r] = __builtin_amdgcn_exp2f(p0[r] - mn); p1[r] = __builtin_amdgcn_exp2f(p1[r] - mn); ps += p0[r] + p1[r]; }
            l = l * alpha + ps;
#pragma unroll
            for (int r = 0; r < 16; ++r) { oacc[0][r] *= alpha; oacc[1][r] *= alpha; }
            f16x8 pf[4];
#pragma unroll
            for (int j = 0; j < 8; ++j) { pf[0][j] = (f16)p0[j]; pf[1][j] = (f16)p0[8 + j]; pf[2][j] = (f16)p1[j]; pf[3][j] = (f16)p1[8 + j]; }
#pragma unroll
            for (int ks = 0; ks < 4; ++ks)
#pragma unroll
                for (int dt = 0; dt < 2; ++dt) {
                    const f16x8 vf = tr_pair(vb + ks * 16 * PVB + dt * 64);
                    oacc[dt] = __builtin_amdgcn_mfma_f32_32x32x16_f16(vf, pf[ks], oacc[dt], 0, 0, 0);
                }
        }
        if (tn >= 0) tile_store<DQK>(R, lds + KB_OFF + (cb ^ 1) * KB_STRIDE, lds + VB_OFF + (cb ^ 1) * VB_STRIDE, tid);
        __syncthreads();
        if (tn < 0) break;
        t = tn; cb ^= 1;
    }
}
__device__ __forceinline__ void store_ot(u16* orow, const f32x16 (&o)[2], int hi) {
#pragma unroll
    for (int dt = 0; dt < 2; ++dt)
#pragma unroll
        for (int a = 0; a < 4; ++a) { u32x2 w; w.x = pg8::pk_f16(o[dt][4 * a], o[dt][4 * a + 1]); w.y = pg8::pk_f16(o[dt][4 * a + 2], o[dt][4 * a + 3]);
            *(u32x2*)(orow + 32 * dt + 8 * a + 4 * hi) = w; }
}
template <int NF> __device__ __forceinline__ void load_qf(f16x8 (&qf)[NF], const f16* qrow, int hi) {
#pragma unroll
    for (int d0 = 0; d0 < NF; ++d0) qf[d0] = *(const f16x8*)(qrow + 16 * d0 + 8 * hi);
}
__device__ __forceinline__ void zero_o(f32x16 (&o)[2]) {
#pragma unroll
    for (int r = 0; r < 16; ++r) { o[0][r] = 0.f; o[1][r] = 0.f; }
}
__device__ __forceinline__ int snake(int i, int G, int c) { return i * G + ((i & 1) ? (G - 1 - c) : c); }
__device__ __forceinline__ unsigned wg_or(LAS unsigned char* lds, unsigned v, int wave, int lane) {
#pragma unroll
    for (int o = 1; o < 64; o <<= 1) v |= __shfl_xor(v, o);
    LAS unsigned* red = (LAS unsigned*)(lds + RED_OFF);
    if (lane == 0) red[wave] = v;
    __syncthreads();
    unsigned r = 0u;
#pragma unroll
    for (int w = 0; w < NWAVES; ++w) r |= red[w];
    __syncthreads();
    return r;
}

__device__ __forceinline__ void l0_attn(LAS unsigned char* lds, const u16* Z0, const u16* QBp, const u16* KVBp, const u16* KRp, const float* bias, const f32x2* rope, const float* sinks, u16* O, int tid, int wave, int lane) {
    const int G = gridDim.x, c = blockIdx.x, hi = lane >> 5, r32 = lane & 31;
    build_bias(lds, bias, 0, tid);
    __syncthreads();
    for (int i = 0;; ++i) {
        const int u = snake(i, G, c); if (u >= 512) break;
        const int qt = 7 - (u >> 6), b = (u >> 3) & 7, h = u & 7, q0 = qt * 256;
        const int qpos = q0 + 32 * wave + r32; const size_t token = (size_t)b * SEQ + qpos;
        f16x8 qf[6];
        load_qf<6>(qf, (const f16*)QBp + token * 768 + h * 96, hi);
        {
#pragma unroll
            for (int j = 0; j < 8; ++j) { const f32x2 cs = rope[qpos * 16 + 8 * hi + j]; const float x1 = (float)qf[4][j], x2 = (float)qf[5][j];
                qf[4][j] = (f16)(x1 * cs.x - x2 * cs.y); qf[5][j] = (f16)(x2 * cs.x + x1 * cs.y); }
        }
        float m = MINIT, l = 0.f; f32x16 o[2]; zero_o(o);
        const int nt = (q0 >> 6) + 4; const unsigned tm = nt >= 32 ? 0xffffffffu : ((1u << nt) - 1u);
        attn_tiles<AT_B, 96>(lds, (const f16*)KVBp + (size_t)b * SEQ * 1024 + h * 128, 1024, (const f16*)KRp + (size_t)b * SEQ * 32, (const f16*)KVBp + (size_t)b * SEQ * 1024 + h * 128 + 64, 1024,
                             qf, qpos, q0 + 32 * wave, tm, 0u, 0, nullptr, m, l, o, tid, lane);
        l += __shfl_xor(l, 32);
        const float inv = 1.0f / l;
#pragma unroll
        for (int r = 0; r < 16; ++r) { o[0][r] *= inv; o[1][r] *= inv; }
        store_ot(O + token * DM + 512 + h * 64, o, hi);
    }
    for (int i = 0;; ++i) {
        const int u = i * G + c; if (u >= 512) break;
        const int qt = u >> 4, b = (u >> 1) & 7, hkv = u & 1, q0 = qt * 64, g = wave & 3, head = hkv * 4 + g;
        const int wq_lo = q0 + 32 * (wave >> 2), qpos = wq_lo + r32; const size_t token = (size_t)b * SEQ + qpos;
        f16x8 qf[4];
        load_qf<4>(qf, (const f16*)Z0 + token * N0 + Z0_QA + head * 64, hi);
        float m = fmaxf(sinks[head] * LOG2E, MINIT), l = hi == 0 ? 1.f : 0.f; f32x16 o[2]; zero_o(o);
        const int t1 = q0 >> 6, t0 = t1 - 2 < 0 ? 0 : t1 - 2; const unsigned tm = ((2u << t1) - 1u) & ~((1u << t0) - 1u);
        const f16* zb = (const f16*)Z0 + (size_t)b * SEQ * N0;
        attn_tiles<AT_A, 64>(lds, zb + Z0_KA + hkv * 64, N0, nullptr, zb + Z0_VA + hkv * 64, N0, qf, qpos, wq_lo, tm, 0u, 0,
                             (const LAS float*)(lds + BT_OFF) + head * BT_HEAD + BT_PAD, m, l, o, tid, lane);
        l += __shfl_xor(l, 32);
        const float inv = 1.0f / l;
#pragma unroll
        for (int r = 0; r < 16; ++r) { o[0][r] *= inv; o[1][r] *= inv; }
        store_ot(O + token * DM + head * 64, o, hi);
    }
}

__device__ __forceinline__ void l1_attn(LAS unsigned char* lds, const u16* Z1, const float* bias, const unsigned* SEL, const unsigned* MSEL, const float* OCMP, u16* O, int tid, int wave, int lane) {
    const int G = gridDim.x, c = blockIdx.x, hi = lane >> 5, r32 = lane & 31;
    build_bias(lds, bias, 8, tid);
    __syncthreads();
    for (int i = 0;; ++i) {
        const int u = snake(i, G, c); if (u >= 512) break;
        const int qt = 31 - (u >> 4), b = (u >> 1) & 7, hkv = u & 1, q0 = qt * 64, g = wave & 3, head = hkv * 4 + g;
        const int wq_lo = q0 + 32 * (wave >> 2), qpos = wq_lo + r32; const size_t token = (size_t)b * SEQ + qpos;
        const f16* zb = (const f16*)Z1 + (size_t)b * SEQ * N1; const f16* zt = (const f16*)Z1 + token * N1;
        f16x8 qf[4];
        load_qf<4>(qf, zt + Z1_QC + head * 64, hi);
        const LAS float* bt = (const LAS float*)(lds + BT_OFF) + head * BT_HEAD + BT_PAD;
        const unsigned sel = SEL[token * 2 + hkv];
        const unsigned tm_s = wg_or(lds, sel, wave, lane);
        f32x16 res[2];
        {
            float m = MINIT, l = 0.f; f32x16 o[2]; zero_o(o);
            attn_tiles<AT_SLC, 64>(lds, zb + Z1_KS + hkv * 64, N1, nullptr, zb + Z1_VS + hkv * 64, N1, qf, qpos, wq_lo, tm_s, sel, 0, bt, m, l, o, tid, lane);
            l += __shfl_xor(l, 32);
            const float g1 = 1.0f / (1.0f + __expf(-(float)zt[Z1_GL + 8 + head])); const float inv = g1 / l;
#pragma unroll
            for (int r = 0; r < 16; ++r) { res[0][r] = o[0][r] * inv; res[1][r] = o[1][r] * inv; }
        }
        {
            float m = MINIT, l = 0.f; f32x16 o[2]; zero_o(o);
            const int t1 = q0 >> 6, t0 = t1 - 4 < 0 ? 0 : t1 - 4; const unsigned tm = (t1 >= 31 ? 0xffffffffu : ((2u << t1) - 1u)) & ~((1u << t0) - 1u);
            attn_tiles<AT_WIN, 64>(lds, zb + Z1_KW + hkv * 64, N1, nullptr, zb + Z1_VW + hkv * 64, N1, qf, qpos, wq_lo, tm, 0u, 0, bt, m, l, o, tid, lane);
            l += __shfl_xor(l, 32);
            const float g2 = 1.0f / (1.0f + __expf(-(float)zt[Z1_GL + 16 + head])); const float inv = g2 / l;
#pragma unroll
            for (int r = 0; r < 16; ++r) { res[0][r] += o[0][r] * inv; res[1][r] += o[1][r] * inv; }
        }
        {
            const float g0 = 1.0f / (1.0f + __expf(-(float)zt[Z1_GL + head]));
            const float* oc = OCMP + token * 512 + head * 64;
#pragma unroll
            for (int dt = 0; dt < 2; ++dt)
#pragma unroll
                for (int a = 0; a < 4; ++a) { const f32x4 tq = *(const f32x4*)(oc + 32 * dt + 8 * a + 4 * hi);
                    res[dt][4 * a] += g0 * tq.x; res[dt][4 * a + 1] += g0 * tq.y; res[dt][4 * a + 2] += g0 * tq.z; res[dt][4 * a + 3] += g0 * tq.w; }
        }
        store_ot(O + token * DM + head * 64, res, hi);
    }
    __syncthreads();
    build_bias(lds, bias, 16, tid);
    __syncthreads();
    for (int i = 0;; ++i) {
        const int u = snake(i, G, c); if (u >= 512) break;
        const int qt = 7 - (u >> 6), b = (u >> 3) & 7, h = u & 7, q0 = qt * 256;
        const int wq_lo = q0 + 32 * wave, qpos = wq_lo + r32; const size_t token = (size_t)b * SEQ + qpos;
        const f16* zb = (const f16*)Z1 + (size_t)b * SEQ * N1; const f16* zt = (const f16*)Z1 + token * N1;
        f16x8 qf[4];
        load_qf<4>(qf, zt + Z1_QD + h * 64, hi);
        const unsigned msel = MSEL[token * 8 + h];
        const unsigned um = wg_or(lds, msel, wave, lane) | (1u << qt);
        unsigned tm = 0u;
#pragma unroll
        for (int n = 0; n < 8; ++n) if ((um >> n) & 1u) tm |= 0xfu << (4 * n);
        float m = MINIT, l = 0.f; f32x16 o[2]; zero_o(o);
        attn_tiles<AT_D, 64>(lds, zb + Z1_KD + h * 64, N1, nullptr, zb + Z1_VD + h * 64, N1, qf, qpos, wq_lo, tm, msel, qt,
                             (const LAS float*)(lds + BT_OFF) + h * BT_HEAD + BT_PAD, m, l, o, tid, lane);
        l += __shfl_xor(l, 32);
        const float inv = 1.0f / l;
#pragma unroll
        for (int r = 0; r < 16; ++r) { o[0][r] *= inv; o[1][r] *= inv; }
        store_ot(O + token * DM + 512 + h * 64, o, hi);
    }
}
}

struct Args { const float* in[41]; float* out; unsigned char* ws; int ph_lo, ph_hi; };
enum { I_X = 0, I_REL = 1, I_L0 = 2, I_L1 = 21 };

__global__ void __launch_bounds__(NTHREADS, 2) fwd(Args args) {
    extern __shared__ __attribute__((aligned(16))) unsigned char lds_raw[];
    LAS unsigned char* lds = (LAS unsigned char*)lds_raw;
    volatile LAS unsigned* MISC = (volatile LAS unsigned*)(lds + MISC_OFF);
    const int tid = threadIdx.x, lane = tid & 63, wave = __builtin_amdgcn_readfirstlane(tid >> 6);
    const int G = gridDim.x, gw = blockIdx.x * NWAVES + wave, NGW = G * NWAVES, gtid = blockIdx.x * NTHREADS + tid, NT = G * NTHREADS;
    unsigned char* ws = args.ws;
    unsigned* ctl = (unsigned*)(ws + WS_CTL);
    for (int u = tid; u < (LDS_BYTES - RING_BYTES) / 4; u += NTHREADS) ((LAS unsigned*)(lds + RING_BYTES))[u] = 0u;
    __syncthreads();
#if ONE_LAUNCH
    XcdBarrier bar = xcd_barrier_post(ctl + 4096, MISC + 8);
#define GRID_BAR() xcd_barrier(bar)
#else
#define GRID_BAR() do {} while (0)
#endif
    const int lo = args.ph_lo, hi = args.ph_hi;
    int ph = 0;
#define IN_PH (lo <= ph && ph < hi)
#define SEAM() do { if (lo <= ph && ph + 1 < hi) GRID_BAR(); ++ph; } while (0)

    LAS float* scr = (LAS float*)(lds + wave * 16384);

#define PHASE(...) do { if (IN_PH) { __VA_ARGS__ } SEAM(); } while (0)
#define GEMM_SITE(EPI, Aptr, Bptr, NN, KK, LDA, ...) do { pg8::Gemm g{(const u16*)(Aptr), (const u16*)(Bptr), M, NN, KK, LDA}; pg8::StaticOrder S; S.init(M, NN, G, (int)blockIdx.x); \
        pg8::EPI E{__VA_ARGS__}; pg8::gemm_phase<pg8::EPI, pg8::StaticOrder, true>(lds, g, S, E); } while (0)
#define CONV_FFN(LBASE, F2BASE) do { \
        conv_matrix(args.in[LBASE + 2], DM, DFF, (u16*)(ws + W_GU1), DM, 1, scr, gw, NGW, lane); \
        conv_matrix(args.in[LBASE + 3], DM, DFF, (u16*)(ws + W_GU1), DM, 2, scr, gw, NGW, lane); \
        conv_matrix(args.in[LBASE + 4], DFF, DM, (u16*)(ws + W_D1), DFF, 0, scr, gw, NGW, lane); \
        conv_matrix(args.in[F2BASE + 2], DM, DFF, (u16*)(ws + W_GU2), DM, 1, scr, gw, NGW, lane); \
        conv_matrix(args.in[F2BASE + 3], DM, DFF, (u16*)(ws + W_GU2), DM, 2, scr, gw, NGW, lane); \
        conv_matrix(args.in[F2BASE + 4], DFF, DM, (u16*)(ws + W_D2), DFF, 0, scr, gw, NGW, lane); } while (0)
#define FFN_BLOCK(WGU, WD, POSTI, NEXTI, HASH) do { \
        PHASE( GEMM_SITE(EpiSwiglu, ws + WS_H, ws + WGU, NGU, DM, DM, (u16*)(ws + WS_ACT), DFF); ); \
        PHASE( GEMM_SITE(EpiF32, ws + WS_ACT, ws + WD, DM, DFF, DFF, (float*)(ws + WS_Y), DM); ); \
        PHASE( norm_rows<true, HASH>(args.out, (const float*)(ws + WS_Y), args.in[POSTI], 0.5f, args.out, HASH ? args.in[NEXTI] : nullptr, (u16*)(ws + WS_H), gw, NGW, lane); ); } while (0)
#define WOUT_BLOCK(POSTI, NEXTI) do { \
        PHASE( GEMM_SITE(EpiF32, ws + WS_H, ws + W_OUT, DM, DM, DM, (float*)(ws + WS_Y), DM); ); \
        PHASE( norm_rows<true, true>(args.out, (const float*)(ws + WS_Y), args.in[POSTI], 1.0f, args.out, args.in[NEXTI], (u16*)(ws + WS_H), gw, NGW, lane); ); } while (0)

    PHASE(
        CONV_FFN(I_L0, I_L0 + 14);
        conv_matrix(args.in[I_L0 + 7], DM, 1184, (u16*)(ws + W_IN), DM, 3, scr, gw, NGW, lane);
        zero_u32x4(ws + W_IN + (size_t)1184 * DM * 2, (size_t)(N0 - 1184) * DM * 2 / 16, gtid, NT);
        conv_matrix(args.in[I_L0 + 10], 256, 768, (u16*)(ws + W_UQ), 256, 5, scr, gw, NGW, lane);
        for (int i = gtid; i < 1024 * 16; i += NT) *(u32x4*)(ws + W_UKV + (size_t)(i >> 4) * 512 + 256 + (i & 15) * 16) = (u32x4){0u, 0u, 0u, 0u};
        conv_matrix(args.in[I_L0 + 12], 128, 1024, (u16*)(ws + W_UKV), 256, 0, scr, gw, NGW, lane);
        conv_matrix(args.in[I_L0 + 13], DM, DM, (u16*)(ws + W_OUT), DM, 0, scr, gw, NGW, lane);
        { float* BIAS = (float*)(ws + WS_BIAS); f32x2* ROPE = (f32x2*)(ws + WS_ROPE);
          for (int i = gtid; i < 24 * 2048; i += NT) { const int slot = i >> 11, d = i & 2047; BIAS[i] = args.in[I_REL][t5_bucket(d) * 24 + slot] * LOG2E; }
          for (int i = gtid; i < 2048 * 16; i += NT) { const int sp = i >> 4, jj = i & 15; const float inv = powf(10000.0f, -(float)(2 * jj) / 32.0f); const float ang = (float)sp * inv;
              ROPE[i] = (f32x2){(float)cos((double)ang), (float)sin((double)ang)}; } }
        norm_rows<false, true>(args.in[I_X], nullptr, nullptr, 0.f, args.out, args.in[I_L0 + 0], (u16*)(ws + WS_H), gw, NGW, lane);
    );
    FFN_BLOCK(W_GU1, W_D1, I_L0 + 1, I_L0 + 5, true);
    PHASE( GEMM_SITE(EpiF16, ws + WS_H, ws + W_IN, N0, DM, DM, (u16*)(ws + WS_Z), N0); );
    PHASE( mla_prep((const u16*)(ws + WS_Z), args.in[I_L0 + 9], args.in[I_L0 + 11], (const f32x2*)(ws + WS_ROPE), (u16*)(ws + WS_CQN), (u16*)(ws + WS_CKVN), (u16*)(ws + WS_KR), gw, NGW, lane); );
    PHASE( GEMM_SITE(EpiF16, ws + WS_CQN, ws + W_UQ, 768, 256, 256, (u16*)(ws + WS_QB), 768);
           GEMM_SITE(EpiF16, ws + WS_CKVN, ws + W_UKV, 1024, 256, 256, (u16*)(ws + WS_KVB), 1024); );
    PHASE( att::l0_attn(lds, (const u16*)(ws + WS_Z), (const u16*)(ws + WS_QB), (const u16*)(ws + WS_KVB), (const u16*)(ws + WS_KR), (const float*)(ws + WS_BIAS), (const f32x2*)(ws + WS_ROPE), args.in[I_L0 + 8], (u16*)(ws + WS_H), tid, wave, lane); );
    WOUT_BLOCK(I_L0 + 6, I_L0 + 14);
    FFN_BLOCK(W_GU2, W_D2, I_L0 + 15, I_L1 + 0, true);
    PHASE(
        CONV_FFN(I_L1, I_L1 + 15);
        conv_matrix(args.in[I_L1 + 7], DM, 2840, (u16*)(ws + W_IN), DM, 4, scr, gw, NGW, lane);
        zero_u32x4(ws + W_IN + (size_t)2840 * DM * 2, (size_t)(N1 - 2840) * DM * 2 / 16, gtid, NT);
        conv_matrix(args.in[I_L1 + 14], DM, DM, (u16*)(ws + W_OUT), DM, 0, scr, gw, NGW, lane);
    );
    FFN_BLOCK(W_GU1, W_D1, I_L1 + 1, I_L1 + 5, true);
    PHASE( GEMM_SITE(EpiF16, ws + WS_H, ws + W_IN, N1, DM, DM, (u16*)(ws + WS_Z), N1); );
    PHASE( l1_compress_hidden((const u16*)(ws + WS_Z), args.in[I_L1 + 8], args.in[I_L1 + 9], args.in[I_L1 + 10], args.in[I_L1 + 12], (float*)(ws + WS_HID), (float*)(ws + WS_KMEAN), gw, NGW, lane); );
    PHASE( l1_compress_out((const float*)(ws + WS_HID), args.in[I_L1 + 11], args.in[I_L1 + 13], (float*)(ws + WS_KCMP), (float*)(ws + WS_VCMP), gw, NGW, lane); );
    PHASE( l1_cmp_attn((const u16*)(ws + WS_Z), (const float*)(ws + WS_KCMP), (const float*)(ws + WS_VCMP), (float*)(ws + WS_OCMP), (float*)(ws + WS_IMP), wave, lane); );
    PHASE( l1_select((const u16*)(ws + WS_Z), (const float*)(ws + WS_IMP), (const float*)(ws + WS_KMEAN), (unsigned*)(ws + WS_SEL), (unsigned*)(ws + WS_MSEL), gtid, NT); );
    PHASE( att::l1_attn(lds, (const u16*)(ws + WS_Z), (const float*)(ws + WS_BIAS), (const unsigned*)(ws + WS_SEL), (const unsigned*)(ws + WS_MSEL), (const float*)(ws + WS_OCMP), (u16*)(ws + WS_H), tid, wave, lane); );
    WOUT_BLOCK(I_L1 + 6, I_L1 + 15);
    FFN_BLOCK(W_GU2, W_D2, I_L1 + 16, 0, false);
}

constexpr int N_PHASES = 64;
extern "C" void kernel_launch(void* const* d_in, const int* in_sizes, int n_in, void* d_out, int out_size, void* d_ws, size_t ws_size, hipStream_t stream) {
    static int grid = 0;
    if (grid == 0) {
        if (n_in != 41 || out_size != M * DM || ws_size < WS_END) { fprintf(stderr, "kernel_launch: unexpected shapes (n_in %d out %d ws %zu)\n", n_in, out_size, ws_size); grid = -1; return; }
        int dev = 0, cus = 0;
        if (hipGetDevice(&dev) != hipSuccess || hipDeviceGetAttribute(&cus, hipDeviceAttributeMultiprocessorCount, dev) != hipSuccess) { grid = -1; return; }
        if (hipFuncSetAttribute((const void*)fwd, hipFuncAttributeMaxDynamicSharedMemorySize, LDS_BYTES) != hipSuccess) { grid = -1; return; }
        int per_cu = 0;
        (void)hipOccupancyMaxActiveBlocksPerMultiprocessor(&per_cu, (const void*)fwd, NTHREADS, LDS_BYTES);
        (void)hipGetLastError();
        grid = cus;
    }
    if (grid < 0) return;
    (void)hipMemsetAsync((char*)d_ws + WS_CTL, 0, CTL_ZERO_BYTES, stream);
    Args a{};
    for (int i = 0; i < 41; ++i) a.in[i] = (const float*)d_in[i];
    a.out = (float*)d_out; a.ws = (unsigned char*)d_ws;
#if ONE_LAUNCH
    a.ph_lo = 0; a.ph_hi = N_PHASES;
    hipLaunchKernelGGL(fwd, dim3(grid), dim3(NTHREADS), LDS_BYTES, stream, a);
#else
    for (int p = 0; p < 28; ++p) { a.ph_lo = p; a.ph_hi = p + 1; hipLaunchKernelGGL(fwd, dim3(grid), dim3(NTHREADS), LDS_BYTES, stream, a); }
#endif
}
```

```cpp
#include <hip/hip_runtime.h>
#include <cstdio>
#include <cstdint>

#ifndef ONE_LAUNCH
#define ONE_LAUNCH 1
#endif

#define LAS __attribute__((address_space(3)))
#define GAS __attribute__((address_space(1)))
typedef unsigned short u16;
typedef _Float16 f16;
typedef _Float16 f16x8 __attribute__((ext_vector_type(8)));
typedef _Float16 f16x4 __attribute__((ext_vector_type(4)));
typedef _Float16 f16x2 __attribute__((ext_vector_type(2)));
typedef float f32x4 __attribute__((ext_vector_type(4)));
typedef float f32x2 __attribute__((ext_vector_type(2)));
typedef unsigned u32x4 __attribute__((ext_vector_type(4)));
typedef unsigned u32x2 __attribute__((ext_vector_type(2)));

constexpr int BATCH = 8, SEQ = 2048, DM = 1024, M = BATCH * SEQ, DFF = 2816;
constexpr int NGU = 2 * DFF;
constexpr int N0 = 1280;
constexpr int N1 = 3072;
constexpr float EPS = 1e-6f;
constexpr float LOG2E = 1.4426950408889634f;
constexpr float QS = 0.125f * 1.4426950408889634f;
constexpr float QS96 = (float)(1.4426950408889634 / 9.797958971132712);
constexpr float NEG = -1e30f;
constexpr int Z0_QA = 0, Z0_KA = 512, Z0_VA = 640, Z0_CQ = 768, Z0_CKV = 1024, Z0_KR = 1152;
constexpr int Z1_QC = 0, Z1_KC = 512, Z1_VC = 640, Z1_KS = 768, Z1_VS = 896, Z1_KW = 1024, Z1_VW = 1152, Z1_QD = 1280, Z1_KD = 1792, Z1_VD = 2304, Z1_GL = 2816;
constexpr int NCMP = 127;

constexpr size_t MiB = 1u << 20;
constexpr size_t WS_CTL = 0, CTL_ZERO_BYTES = 1 * MiB;
constexpr size_t WS_BIAS = 1 * MiB;
constexpr size_t WS_ROPE = 1 * MiB + 256 * 1024;
constexpr size_t WS_PEB  = 1 * MiB + 768 * 1024;
constexpr size_t WS_W = 2 * MiB;
constexpr size_t W_GU1 = WS_W, W_D1 = W_GU1 + 11 * MiB, W_GU2 = W_D1 + 5632 * 1024, W_D2 = W_GU2 + 11 * MiB, W_IN = W_D2 + 5632 * 1024;
constexpr size_t W_OUT = W_IN + 6 * MiB, W_UQ = W_OUT + 2 * MiB, W_UKV = W_UQ + 512 * 1024, W_C1 = W_UKV + 512 * 1024, W_END = W_C1 + 2 * MiB;
constexpr size_t WS_H = 48 * MiB;
constexpr size_t WS_ACT = 80 * MiB;
constexpr size_t WS_Z = WS_ACT;
constexpr size_t WS_CQN = 120 * MiB, WS_CKVN = 128 * MiB, WS_KR = 136 * MiB, WS_QB = 137 * MiB;
constexpr size_t WS_Y = 176 * MiB;
constexpr size_t WS_KVB = WS_Y;
constexpr size_t WS_IMP = WS_Y;
constexpr size_t WS_OCMP = WS_Y + 16 * MiB;
constexpr size_t WS_MISC = 240 * MiB;
constexpr size_t WS_KCMP = WS_MISC, WS_VCMP = WS_MISC + 1 * MiB;
constexpr size_t WS_HID = WS_MISC + 2 * MiB;
constexpr size_t WS_SEL = WS_MISC + 8 * MiB;
constexpr size_t WS_MSEL = WS_MISC + 9 * MiB;
constexpr size_t WS_KMEAN = WS_MISC + 10 * MiB;
constexpr size_t WS_END = 256 * MiB;
static_assert(W_END <= WS_H && WS_QB + (size_t)M * 768 * 2 <= WS_Y && WS_OCMP + (size_t)M * 512 * 4 <= WS_MISC, "ws map");

constexpr int NWAVES = 8, NTHREADS = 512;
constexpr int LDS_BYTES = 147456;
constexpr int RING_BYTES = 131072;
constexpr int MISC_OFF = RING_BYTES + 320;

namespace pg8 {
constexpr int BM = 256, BK = 64, HALF = 128, HTB = HALF * BK * 2, STAGE_BYTES = 8 * HTB, NXCD = 8, WGM = 8;
__host__ __device__ __forceinline__ int lds_byte(int r, int c) { const int st = (r >> 4) * 2 + (c >> 5), rr = r & 15, cc = c & 31, ob = rr * 64 + cc * 2; return st * 1024 + (ob ^ (((ob >> 9) & 1) << 5)); }
__host__ __device__ __forceinline__ void stage_rc(int b, int& R, int& C) { const int st = b / 1024, sb = b % 1024, swz = sb ^ (((sb >> 9) & 1) << 5); R = (st >> 1) * 16 + swz / 64; C = (st & 1) * 32 + (swz % 64) / 2; }
__host__ __device__ __forceinline__ int perm32(int rho) { const int n = rho >> 4, i = rho & 15; return 8 * (i >> 2) + 4 * n + (i & 3); }

struct Unit { int pm, pn; };
struct Gemm { const u16* A; const u16* Bt; int M, N, K, lda; };

struct StaticOrder {
    int nM, nN, nwg, G, c;
    __host__ __device__ void init(int M_, int N_, int G_, int c_) { nM = M_ / BM; nN = N_ / BM; nwg = nM * nN; G = G_; c = c_; }
    __host__ __device__ bool next(int i, Unit& u) const {
        const long L = (long)i * G + c; if (L >= nwg) return false;
        int wgid = (int)L; { const int q = nwg / NXCD, r = nwg % NXCD, xcd = wgid % NXCD, off = wgid / NXCD; wgid = (xcd < r ? xcd * (q + 1) : r * (q + 1) + (xcd - r) * q) + off; }
        const int nig = WGM * nN, gid = wgid / nig, fm = gid * WGM, gsz = (nM - fm) < WGM ? (nM - fm) : WGM;
        u.pm = fm + ((wgid % nig) % gsz); u.pn = (wgid % nig) / gsz; return true;
    }
    __device__ __forceinline__ void a_ready(const Unit&) const {}
    __device__ __forceinline__ void done(const Unit&) const {}
};

__device__ __forceinline__ unsigned pk_f16(float lo, float hi) { f16x2 v = {(f16)lo, (f16)hi}; return __builtin_bit_cast(unsigned, v); }

struct EpiF16 {
    static constexpr bool PERM = true;
    u16* O; int ldc;
    __device__ __forceinline__ void operator()(const f32x4 (&acc)[2][2][4][2], const Unit& u, int wr, int wc, int fr, int fq) const {
        const int row0 = u.pm * BM + wr * 64 + fr, col0 = u.pn * BM + wc * 32 + 8 * fq;
#pragma unroll
        for (int ai = 0; ai < 2; ++ai)
#pragma unroll
            for (int m = 0; m < 4; ++m) { u16* rowp = O + (size_t)(row0 + ai * HALF + m * 16) * ldc + col0;
#pragma unroll
                for (int bj = 0; bj < 2; ++bj) { const f32x4 v0 = acc[ai][bj][m][0], v1 = acc[ai][bj][m][1];
                    u32x4 w; w.x = pk_f16(v0[0], v0[1]); w.y = pk_f16(v0[2], v0[3]); w.z = pk_f16(v1[0], v1[1]); w.w = pk_f16(v1[2], v1[3]);
                    *(u32x4*)(rowp + bj * HALF) = w; } }
    }
};
__device__ __forceinline__ float silu_mul(float g, float u) { return g * u * __builtin_amdgcn_rcpf(1.0f + __builtin_amdgcn_exp2f(-g * LOG2E)); }
struct EpiSwiglu {
    static constexpr bool PERM = true;
    u16* O; int ldc;
    __device__ __forceinline__ void operator()(const f32x4 (&acc)[2][2][4][2], const Unit& u, int wr, int wc, int fr, int fq) const {
        const int row0 = u.pm * BM + wr * 64 + fr, col0 = u.pn * HALF + wc * 32 + 8 * fq;
#pragma unroll
        for (int ai = 0; ai < 2; ++ai)
#pragma unroll
            for (int m = 0; m < 4; ++m) { u16* rowp = O + (size_t)(row0 + ai * HALF + m * 16) * ldc + col0;
                const f32x4 g0 = acc[ai][0][m][0], g1 = acc[ai][0][m][1], u0 = acc[ai][1][m][0], u1 = acc[ai][1][m][1];
                u32x4 w; w.x = pk_f16(silu_mul(g0[0], u0[0]), silu_mul(g0[1], u0[1])); w.y = pk_f16(silu_mul(g0[2], u0[2]), silu_mul(g0[3], u0[3]));
                w.z = pk_f16(silu_mul(g1[0], u1[0]), silu_mul(g1[1], u1[1])); w.w = pk_f16(silu_mul(g1[2], u1[2]), silu_mul(g1[3], u1[3]));
                *(u32x4*)rowp = w; }
    }
};
struct EpiF32 {
    static constexpr bool PERM = false;
    float* C; int ldc;
    __device__ __forceinline__ void operator()(const f32x4 (&acc)[2][2][4][2], const Unit& u, int wr, int wc, int fr, int fq) const {
        const int row0 = u.pm * BM + wr * 64 + fr, col0 = u.pn * BM + wc * 32 + 4 * fq;
#pragma unroll
        for (int ai = 0; ai < 2; ++ai)
#pragma unroll
            for (int m = 0; m < 4; ++m) { float* rowp = C + (size_t)(row0 + ai * HALF + m * 16) * ldc + col0;
#pragma unroll
                for (int bj = 0; bj < 2; ++bj)
#pragma unroll
                    for (int n = 0; n < 2; ++n) *(f32x4*)(rowp + bj * HALF + n * 16) = acc[ai][bj][m][n]; }
    }
};

template <class Epi, class Sched, bool ALIGN_EPI>
__device__ __forceinline__ void gemm_phase(LAS unsigned char* lds, const Gemm g, const Sched& S, const Epi& E) {
    const int tid = threadIdx.x, wid = __builtin_amdgcn_readfirstlane(tid >> 6), lane = tid & 63, wr = wid >> 2, wc = wid & 3, fr = lane & 15, fq = lane >> 4;
    const int K = g.K, nt = K / BK, lda = g.lda;
    unsigned voffA[2], voffB[2];
#pragma unroll
    for (int i = 0; i < 2; ++i) { int R, C; stage_rc(tid * 16 + i * 8192, R, C); const int Rb = Epi::PERM ? ((R & ~31) + perm32(R & 31)) : R;
        voffA[i] = (unsigned)(R * lda + C) * 2u; voffB[i] = (unsigned)(Rb * K + C) * 2u; }
    const size_t kstep = (size_t)(BK * 2);
    const size_t hstepA = (size_t)HALF * lda * 2, hstepB = (size_t)HALF * K * 2;
    const size_t tstepA = 2 * hstepA, tstepB = 2 * hstepB;
    const unsigned ldsw = (unsigned)wid * 1024u;
    const int aoff = lds_byte(wr * 64 + fr, fq * 8), boff = lds_byte(wc * 32 + fr, fq * 8);
#define PG8_SA(b, h) (((b) * 2 + (h)) * HTB)
#define PG8_SB(b, h) ((4 + (b) * 2 + (h)) * HTB)
#define PG8_STAGE(bufoff, gbase, voff) do { _Pragma("unroll") for (int _i = 0; _i < 2; ++_i) \
        __builtin_amdgcn_global_load_lds((const unsigned*)((const char*)(gbase) + (voff)[_i]), (LAS unsigned*)(lds + (bufoff) + ldsw + _i * 8192), 16, 0, 0); } while (0)
#define PG8_LDA(dst, b, h) do { _Pragma("unroll") for (int m = 0; m < 4; ++m) _Pragma("unroll") for (int k = 0; k < 2; ++k) dst[m][k] = *(const LAS f16x8*)(lds + PG8_SA(b, h) + aoff + m * 2048 + k * 1024); } while (0)
#define PG8_LDB(dst, b, h) do { _Pragma("unroll") for (int n = 0; n < 2; ++n) _Pragma("unroll") for (int k = 0; k < 2; ++k) dst[n][k] = *(const LAS f16x8*)(lds + PG8_SB(b, h) + boff + n * 2048 + k * 1024); } while (0)
#define PG8_MMA(ai, bj, At, Bt) do { __builtin_amdgcn_s_setprio(1); _Pragma("unroll") for (int m = 0; m < 4; ++m) _Pragma("unroll") for (int n = 0; n < 2; ++n) _Pragma("unroll") for (int k = 0; k < 2; ++k) \
        acc[ai][bj][m][n] = __builtin_amdgcn_mfma_f32_16x16x32_f16(Bt[n][k], At[m][k], acc[ai][bj][m][n], 0, 0, 0); __builtin_amdgcn_s_setprio(0); } while (0)
#define PG8_WAIT_V(n) asm volatile("s_waitcnt vmcnt(" #n ")" ::: "memory")
#define PG8_WAIT_L(n) asm volatile("s_waitcnt lgkmcnt(" #n ")" ::: "memory")
#define PG8_BAR __builtin_amdgcn_s_barrier()
#define PG8_SCHED __builtin_amdgcn_sched_barrier(0)
    Unit cur, nxt; int ui = 0;
    if (!S.next(0, cur)) return;
    f32x4 acc[2][2][4][2];
#pragma unroll
    for (int a = 0; a < 2; ++a)
#pragma unroll
        for (int b = 0; b < 2; ++b)
#pragma unroll
            for (int m = 0; m < 4; ++m)
#pragma unroll
                for (int n = 0; n < 2; ++n) acc[a][b][m][n] = (f32x4){0.f, 0.f, 0.f, 0.f};
    f16x8 At[4][2], B0[2][2], B1[2][2];
    const char* cA = (const char*)g.A + (size_t)cur.pm * tstepA; const char* cB = (const char*)g.Bt + (size_t)cur.pn * tstepB;
    S.a_ready(cur);
    PG8_STAGE(PG8_SB(0, 0), cB, voffB); PG8_STAGE(PG8_SB(0, 1), cB + hstepB, voffB); PG8_STAGE(PG8_SA(0, 0), cA, voffA); PG8_STAGE(PG8_SA(0, 1), cA + hstepA, voffA);
    if (wr == 1) PG8_BAR;
    PG8_WAIT_V(2); PG8_BAR;
    PG8_STAGE(PG8_SB(1, 0), cB + kstep, voffB); PG8_STAGE(PG8_SA(1, 0), cA + kstep, voffA); PG8_STAGE(PG8_SB(1, 1), cB + hstepB + kstep, voffB);
    PG8_WAIT_V(6); PG8_BAR;
    for (;;) {
        const bool has_next = S.next(ui + 1, nxt);
        const char* nA = has_next ? (const char*)g.A + (size_t)nxt.pm * tstepA : cA; const char* nB = has_next ? (const char*)g.Bt + (size_t)nxt.pn * tstepB : cB;
        for (int t = 0; t < nt; t += 2) {
            const bool last = (t == nt - 2);
            const char* a1 = cA + (size_t)(t + 1) * kstep;
            const char* a2 = last ? nA : cA + (size_t)(t + 2) * kstep; const char* b2 = last ? nB : cB + (size_t)(t + 2) * kstep;
            const char* a3 = a2 + kstep; const char* b3 = b2 + kstep;
            if (last && has_next) S.a_ready(nxt);
            PG8_LDB(B0, 0, 0); PG8_LDB(B1, 0, 1); PG8_SCHED; PG8_LDA(At, 0, 0); PG8_STAGE(PG8_SA(1, 1), a1 + hstepA, voffA);
            PG8_WAIT_V(8); PG8_WAIT_L(0); PG8_BAR; PG8_MMA(0, 0, At, B0); PG8_MMA(0, 1, At, B1); PG8_BAR; PG8_SCHED;
            PG8_LDA(At, 0, 1); PG8_STAGE(PG8_SB(0, 0), b2, voffB); PG8_STAGE(PG8_SB(0, 1), b2 + hstepB, voffB); PG8_STAGE(PG8_SA(0, 0), a2, voffA);
            PG8_WAIT_V(8); PG8_WAIT_L(0); PG8_BAR; PG8_MMA(1, 0, At, B0); PG8_MMA(1, 1, At, B1); PG8_BAR; PG8_SCHED;
            PG8_LDB(B0, 1, 0); PG8_LDB(B1, 1, 1); PG8_SCHED; PG8_LDA(At, 1, 0); PG8_STAGE(PG8_SA(0, 1), a2 + hstepA, voffA);
            PG8_WAIT_V(8); PG8_WAIT_L(0); PG8_BAR; PG8_MMA(0, 0, At, B0); PG8_MMA(0, 1, At, B1); PG8_BAR; PG8_SCHED;
            PG8_LDA(At, 1, 1); PG8_STAGE(PG8_SB(1, 0), b3, voffB); PG8_STAGE(PG8_SB(1, 1), b3 + hstepB, voffB); PG8_STAGE(PG8_SA(1, 0), a3, voffA);
            PG8_WAIT_V(8); PG8_WAIT_L(0); PG8_BAR; PG8_MMA(1, 0, At, B0); PG8_MMA(1, 1, At, B1); PG8_BAR; PG8_SCHED;
        }
        if constexpr (ALIGN_EPI) { if (wr == 0) PG8_BAR; }
        E(acc, cur, wr, wc, fr, fq); S.done(cur);
        if (!has_next) break;
#pragma unroll
        for (int a = 0; a < 2; ++a)
#pragma unroll
            for (int b = 0; b < 2; ++b)
#pragma unroll
                for (int m = 0; m < 4; ++m)
#pragma unroll
                    for (int n = 0; n < 2; ++n) acc[a][b][m][n] = (f32x4){0.f, 0.f, 0.f, 0.f};
        cur = nxt; cA = nA; cB = nB; ++ui;
        if constexpr (ALIGN_EPI) { if (wr == 1) PG8_BAR; }
    }
    PG8_WAIT_V(0);
    if constexpr (!ALIGN_EPI) { if (wr == 0) PG8_BAR; }
    PG8_BAR;
#undef PG8_SA
#undef PG8_SB
#undef PG8_STAGE
#undef PG8_LDA
#undef PG8_LDB
#undef PG8_MMA
#undef PG8_WAIT_V
#undef PG8_WAIT_L
#undef PG8_BAR
#undef PG8_SCHED
}
}

#define XB_TMO      128
#define XB_XCNT(j)  (256  + 64 * (j))
#define XB_XSUB(j)  (1280 + 64 * (j))
#define XB_XGEN(j)  (2304 + 64 * (j))
#define XB_TOP      3328
#define XB_TOPGEN   3392
#define XCD_BAR_WORDS 3456
#define XB_SPIN_CAP (1u << 23)
__device__ __forceinline__ unsigned xb_ld(unsigned* p)              { return __hip_atomic_load(p, __ATOMIC_RELAXED, __HIP_MEMORY_SCOPE_AGENT); }
__device__ __forceinline__ unsigned xb_add(unsigned* p, unsigned v) { return __hip_atomic_fetch_add(p, v, __ATOMIC_RELAXED, __HIP_MEMORY_SCOPE_AGENT); }
__device__ __forceinline__ unsigned xb_xcc_id() { return (unsigned)__builtin_amdgcn_s_getreg((3 << 11) | 20) & 0xFu; }
#define XB_SPIN(cond, bar) do { unsigned _sp = 0; while (cond) { __builtin_amdgcn_s_sleep(1); \
    if ((++_sp & 255u) == 0u) { if (xb_ld(&(bar)[XB_TMO])) break; if (_sp > XB_SPIN_CAP) { atomicAdd(&(bar)[XB_TMO], 1u); break; } } } } while (0)
struct XcdBarrier { unsigned* bar; unsigned x; volatile LAS unsigned* st; };
__device__ __forceinline__ XcdBarrier xcd_barrier_post(unsigned* bar, volatile LAS unsigned* st) {
    XcdBarrier b; b.bar = bar; b.x = xb_xcc_id(); b.st = st;
    if (threadIdx.x == 0) (void)xb_add(&bar[XB_XCNT(b.x)], 1u);
    return b;
}
__device__ __forceinline__ void xcd_barrier_complete(unsigned* bar, unsigned x, unsigned& nloc, unsigned& nx) {
    const unsigned G = gridDim.x * gridDim.y * gridDim.z;
    unsigned sum, cnt, mine, sp = 0u;
    for (;;) {
        sum = 0u; cnt = 0u; mine = 0u;
#pragma unroll
        for (unsigned j = 0; j < 16; ++j) { const unsigned c = xb_ld(&bar[XB_XCNT(j)]); sum += c; cnt += (c > 0u) ? 1u : 0u; mine = (j == x) ? c : mine; }
        if (sum == G) break;
        __builtin_amdgcn_s_sleep(1);
        if ((++sp & 255u) == 0u) { if (xb_ld(&bar[XB_TMO])) break; if (sp > XB_SPIN_CAP) { atomicAdd(&bar[XB_TMO], 1u); break; } }
    }
    nloc = mine > 0u ? mine : 1u; nx = cnt > 0u ? cnt : 1u;
}
__device__ __forceinline__ void xcd_barrier(const XcdBarrier& b) {
    asm volatile("s_waitcnt vmcnt(0)" ::: "memory");
    __syncthreads();
    if (threadIdx.x == 0) {
        unsigned* bar = b.bar;
        __builtin_amdgcn_s_waitcnt(0);
        unsigned nloc = b.st[0], nx = b.st[1];
        if (nloc == 0u) { xcd_barrier_complete(bar, b.x, nloc, nx); b.st[0] = nloc; b.st[1] = nx; }
        const unsigned old = xb_add(&bar[XB_XSUB(b.x)], 1u);
        const unsigned gen = old / nloc;
        if (old + 1u == (gen + 1u) * nloc) {
            __builtin_amdgcn_fence(__ATOMIC_RELEASE, "agent");
            asm volatile("s_waitcnt vmcnt(0)" ::: "memory");
            const unsigned og = xb_add(&bar[XB_TOP], 1u);
            const unsigned tg = og / nx;
            if (og + 1u == (tg + 1u) * nx) xb_add(&bar[XB_TOPGEN], 1u);
            else XB_SPIN(xb_ld(&bar[XB_TOPGEN]) == tg, bar);
            __builtin_amdgcn_fence(__ATOMIC_ACQUIRE, "agent");
            xb_add(&bar[XB_XGEN(b.x)], 1u);
            asm volatile("s_waitcnt vmcnt(0)" ::: "memory");
        } else {
            XB_SPIN(xb_ld(&bar[XB_XGEN(b.x)]) == gen, bar);
            __builtin_amdgcn_fence(__ATOMIC_ACQUIRE, "agent");
            asm volatile("s_waitcnt vmcnt(0)" ::: "memory");
        }
    }
    __syncthreads();
}

__device__ __forceinline__ float wave_sum(float v) {
#pragma unroll
    for (int o = 1; o < 64; o <<= 1) v += __shfl_xor(v, o);
    return v;
}
__device__ __forceinline__ int t5_bucket(int n) {
    if (n < 16) return n;
    int b = 16;
    b += (n >= 21); b += (n >= 27); b += (n >= 35); b += (n >= 46); b += (n >= 59); b += (n >= 77); b += (n >= 99); b += (n >= 128);
    b += (n >= 166); b += (n >= 216); b += (n >= 280); b += (n >= 363); b += (n >= 470); b += (n >= 609); b += (n >= 790);
    return b;
}

__device__ __forceinline__ int conv_row(int mode, int n) {
    if (mode == 1) return 256 * (n >> 7) + (n & 127);
    if (mode == 2) return 256 * (n >> 7) + 128 + (n & 127);
    if (mode == 4) return n < 1280 ? n : (n < 1304 ? 2816 + (n - 1280) : n - 24);
    return n;
}
__device__ __forceinline__ float conv_scale(int mode, int n) {
    if (mode == 3) return n < 512 ? QS : 1.0f;
    if (mode == 4) return (n < 512 || (n >= 1304 && n < 1816)) ? QS : 1.0f;
    if (mode == 5) return QS96;
    return 1.0f;
}
__device__ __forceinline__ void conv_matrix(const float* W, int K, int N, u16* WT, int ldk, int mode, LAS float* scr, int gw, int NGW, int lane) {
    const int nblk = (N + 31) / 32, nitems = (K / 64) * nblk;
    for (int item = gw; item < nitems; item += NGW) {
        const int kb = item / nblk, nb = item % nblk, k0 = 64 * kb, n0 = 32 * nb;
        const int nl = n0 + (lane & 31);
#pragma unroll 8
        for (int i = 0; i < 32; ++i) { const int kk = 2 * i + (lane >> 5); scr[kk * 33 + (lane & 31)] = (nl < N) ? W[(size_t)(k0 + kk) * N + nl] : 0.f; }
        asm volatile("s_waitcnt lgkmcnt(0)" ::: "memory");
        const int c = lane & 7;
#pragma unroll
        for (int j = 0; j < 4; ++j) { const int n = (lane >> 3) + 8 * j; const LAS float* s = scr + (8 * c) * 33 + n;
            if (n0 + n < N) { const float sc = conv_scale(mode, n0 + n);
                u32x4 o; o.x = pg8::pk_f16(s[0 * 33] * sc, s[1 * 33] * sc); o.y = pg8::pk_f16(s[2 * 33] * sc, s[3 * 33] * sc); o.z = pg8::pk_f16(s[4 * 33] * sc, s[5 * 33] * sc); o.w = pg8::pk_f16(s[6 * 33] * sc, s[7 * 33] * sc);
                *(u32x4*)(WT + (size_t)conv_row(mode, n0 + n) * ldk + k0 + 8 * c) = o; } }
        asm volatile("s_waitcnt lgkmcnt(0)" ::: "memory");
    }
}
__device__ __forceinline__ void zero_u32x4(void* p, size_t n16, int gtid, int NT) { for (size_t i = gtid; i < n16; i += NT) ((u32x4*)p)[i] = (u32x4){0u, 0u, 0u, 0u}; }

template <bool HASY, bool HASH>
__device__ __forceinline__ void norm_rows(const float* Xin, const float* Y, const float* post, float w, float* Xout, const float* pre, u16* H, int gw, int NGW, int lane) {
    for (int m = gw; m < M; m += NGW) {
        const f32x4* xr = (const f32x4*)(Xin + (size_t)m * DM) + lane;
        f32x4 x[4];
#pragma unroll
        for (int j = 0; j < 4; ++j) x[j] = xr[64 * j];
        if (HASY) {
            const f32x4* yr = (const f32x4*)(Y + (size_t)m * DM) + lane; f32x4 y[4]; float ss = 0.f;
#pragma unroll
            for (int j = 0; j < 4; ++j) { y[j] = yr[64 * j]; ss += (y[j].x * y[j].x + y[j].y * y[j].y) + (y[j].z * y[j].z + y[j].w * y[j].w); }
            const float rstd = 1.0f / sqrtf(wave_sum(ss) * (1.0f / DM) + EPS) * w;
#pragma unroll
            for (int j = 0; j < 4; ++j) { const f32x4 pg = ((const f32x4*)post)[lane + 64 * j]; x[j] = x[j] + y[j] * rstd * pg; }
        }
        f32x4* xo = (f32x4*)(Xout + (size_t)m * DM) + lane;
#pragma unroll
        for (int j = 0; j < 4; ++j) xo[64 * j] = x[j];
        if (HASH) {
            float ss = 0.f;
#pragma unroll
            for (int j = 0; j < 4; ++j) ss += (x[j].x * x[j].x + x[j].y * x[j].y) + (x[j].z * x[j].z + x[j].w * x[j].w);
            const float rstd = 1.0f / sqrtf(wave_sum(ss) * (1.0f / DM) + EPS);
            u32x2* ho = (u32x2*)(H + (size_t)m * DM) + lane;
#pragma unroll
            for (int j = 0; j < 4; ++j) { const f32x4 pg = ((const f32x4*)pre)[lane + 64 * j]; const f32x4 h = x[j] * rstd * pg;
                u32x2 o; o.x = pg8::pk_f16(h.x, h.y); o.y = pg8::pk_f16(h.z, h.w); ho[64 * j] = o; }
        }
    }
}

__device__ __forceinline__ void mla_prep(const u16* Z0, const float* qn, const float* kvn, const f32x2* rope, u16* CQN, u16* CKVN, u16* KRb, int gw, int NGW, int lane) {
    for (int m = gw; m < M; m += NGW) {
        const f16* z = (const f16*)Z0 + (size_t)m * N0;
        { const f16x4 c = *(const f16x4*)(z + Z0_CQ + 4 * lane); const float c0 = (float)c[0], c1 = (float)c[1], c2 = (float)c[2], c3 = (float)c[3];
          const float rstd = 1.0f / sqrtf(wave_sum((c0 * c0 + c1 * c1) + (c2 * c2 + c3 * c3)) * (1.0f / 256.f) + EPS);
          const f32x4 g = ((const f32x4*)qn)[lane];
          u32x2 o; o.x = pg8::pk_f16(c0 * rstd * g.x, c1 * rstd * g.y); o.y = pg8::pk_f16(c2 * rstd * g.z, c3 * rstd * g.w);
          *((u32x2*)(CQN + (size_t)m * 256) + lane) = o; }
        { const f16x2 c = *(const f16x2*)(z + Z0_CKV + 2 * lane); const float c0 = (float)c[0], c1 = (float)c[1];
          const float rstd = 1.0f / sqrtf(wave_sum(c0 * c0 + c1 * c1) * (1.0f / 128.f) + EPS);
          const f32x2 g = ((const f32x2*)kvn)[lane];
          unsigned* o = (unsigned*)(CKVN + (size_t)m * 256);
          o[lane] = pg8::pk_f16(c0 * rstd * g.x, c1 * rstd * g.y); o[64 + lane] = 0u; }
        if (lane < 16) { const float x1 = (float)z[Z0_KR + lane], x2 = (float)z[Z0_KR + 16 + lane]; const f32x2 cs = rope[(m & (SEQ - 1)) * 16 + lane];
          f16* o = (f16*)KRb + (size_t)m * 32; o[lane] = (f16)(x1 * cs.x - x2 * cs.y); o[16 + lane] = (f16)(x2 * cs.x + x1 * cs.y); }
    }
}

template <int DQK, class KeyFn, class ScoreFn>
__device__ __forceinline__ void naive_attend(const float (&q)[DQK], float& m, float& l, float (&o)[64], int klo, int khi, const KeyFn& kf, const ScoreFn& sf) {
    for (int kp = klo; kp <= khi; ++kp) {
        const f16x8* kr = (const f16x8*)kf.k(kp);
        float s = 0.f;
#pragma unroll
        for (int c = 0; c < 8; ++c) { const f16x8 kv = kr[c];
#pragma unroll
            for (int j = 0; j < 8; ++j) s += q[c * 8 + j] * (float)kv[j]; }
        if constexpr (DQK == 96) { const f16x8* k2 = (const f16x8*)kf.k2(kp);
#pragma unroll
            for (int c = 0; c < 4; ++c) { const f16x8 kv = k2[c];
#pragma unroll
                for (int j = 0; j < 8; ++j) s += q[64 + c * 8 + j] * (float)kv[j]; } }
        if (sf(kp, s)) {
            const float mn = fmaxf(m, s), a = __builtin_amdgcn_exp2f(m - mn), p = __builtin_amdgcn_exp2f(s - mn);
            m = mn; l = l * a + p;
            const f16x8* vr = (const f16x8*)kf.v(kp);
#pragma unroll
            for (int c = 0; c < 8; ++c) { const f16x8 vv = vr[c];
#pragma unroll
                for (int j = 0; j < 8; ++j) o[c * 8 + j] = o[c * 8 + j] * a + p * (float)vv[j]; }
        }
    }
}
struct KeyZ { const f16* kbase; const f16* vbase; int pitch;
    __device__ __forceinline__ const f16* k(int kp) const { return kbase + (size_t)kp * pitch; }
    __device__ __forceinline__ const f16* k2(int) const { return nullptr; }
    __device__ __forceinline__ const f16* v(int kp) const { return vbase + (size_t)kp * pitch; } };
struct KeyMLA { const f16* kvb; const f16* kr;
    __device__ __forceinline__ const f16* k(int kp) const { return kvb + (size_t)kp * 1024; }
    __device__ __forceinline__ const f16* k2(int kp) const { return kr + (size_t)kp * 32; }
    __device__ __forceinline__ const f16* v(int kp) const { return kvb + (size_t)kp * 1024 + 64; } };

__device__ __forceinline__ void store_o64(u16* dst, const float (&o)[64], float sc) {
#pragma unroll
    for (int c = 0; c < 8; ++c) { u32x4 w; w.x = pg8::pk_f16(o[c * 8 + 0] * sc, o[c * 8 + 1] * sc); w.y = pg8::pk_f16(o[c * 8 + 2] * sc, o[c * 8 + 3] * sc);
        w.z = pg8::pk_f16(o[c * 8 + 4] * sc, o[c * 8 + 5] * sc); w.w = pg8::pk_f16(o[c * 8 + 6] * sc, o[c * 8 + 7] * sc); ((u32x4*)dst)[c] = w; }
}
template <int N> __device__ __forceinline__ void load_q(float (&q)[N], const f16* src, int off, int cnt8) {
#pragma unroll
    for (int c = 0; c < cnt8; ++c) { const f16x8 v = ((const f16x8*)src)[c];
#pragma unroll
        for (int j = 0; j < 8; ++j) q[off + c * 8 + j] = (float)v[j]; }
}

__device__ __forceinline__ void l0_attn_naive(const u16* Z0, const u16* QBp, const u16* KVBp, const u16* KRp, const float* bias, const f32x2* rope, const float* sinks, u16* O, int wave, int lane) {
    for (int tb = blockIdx.x; tb < M / 64; tb += gridDim.x) {
        const int token = tb * 64 + lane, b = token / SEQ, qpos = token % SEQ, qmin = (tb * 64) % SEQ, head = wave, hkv = head >> 2;
        {
            float q[64], o[64];
            load_q<64>(q, (const f16*)Z0 + (size_t)token * N0 + Z0_QA + head * 64, 0, 8);
#pragma unroll
            for (int d = 0; d < 64; ++d) o[d] = 0.f;
            float m = sinks[head] * LOG2E, l = 1.f;
            const KeyZ kf{(const f16*)Z0 + (size_t)b * SEQ * N0 + Z0_KA + hkv * 64, (const f16*)Z0 + (size_t)b * SEQ * N0 + Z0_VA + hkv * 64, N0};
            const float* bt = bias + (0 + head) * 2048;
            auto sf = [&](int kp, float& s) -> bool { const int d = qpos - kp; if (d < 0 || d >= 128) return false; s += bt[d]; return true; };
            const int klo = qmin - 127 < 0 ? 0 : qmin - 127;
            naive_attend<64>(q, m, l, o, klo, qmin + 63, kf, sf);
            store_o64(O + (size_t)token * DM + head * 64, o, 1.0f / l);
        }
        {
            float q[96], o[64];
            load_q<96>(q, (const f16*)QBp + (size_t)token * 768 + head * 96, 0, 12);
#pragma unroll
            for (int i = 0; i < 16; ++i) { const f32x2 cs = rope[qpos * 16 + i]; const float x1 = q[64 + i], x2 = q[80 + i]; q[64 + i] = x1 * cs.x - x2 * cs.y; q[80 + i] = x2 * cs.x + x1 * cs.y; }
#pragma unroll
            for (int d = 0; d < 64; ++d) o[d] = 0.f;
            float m = NEG, l = 0.f;
            const KeyMLA kf{(const f16*)KVBp + (size_t)b * SEQ * 1024 + head * 128, (const f16*)KRp + (size_t)b * SEQ * 32};
            auto sf = [&](int kp, float&) -> bool { return kp <= qpos; };
            naive_attend<96>(q, m, l, o, 0, qmin + 63, kf, sf);
            store_o64(O + (size_t)token * DM + 512 + head * 64, o, 1.0f / l);
        }
    }
}

__device__ __forceinline__ void l1_compress_hidden(const u16* Z1, const float* pe_k, const float* pe_v, const float* wk1, const float* wv1, float* HID, float* KMEAN, int gw, int NGW, int lane) {
    const int nitems = 2 * BATCH * NCMP * 2 * 4;
    for (int it = gw; it < nitems; it += NGW) {
        const int nb = it & 3, row = (it >> 2) % (BATCH * NCMP * 2), sel = (it >> 2) / (BATCH * NCMP * 2);
        const int hkv = row & 1, c = (row >> 1) % NCMP, b = (row >> 1) / NCMP, n = nb * 64 + lane;
        const f16* x = (const f16*)Z1 + ((size_t)b * SEQ + 16 * c) * N1 + (sel ? Z1_VC : Z1_KC) + hkv * 64;
        const float* pe = sel ? pe_v : pe_k; const float* w1 = sel ? wv1 : wk1;
        float acc = 0.f;
        for (int i = 0; i < 32; ++i) {
            const f16* xr = x + (size_t)i * N1;
#pragma unroll 8
            for (int d = 0; d < 64; ++d) acc += ((float)xr[d] + pe[i * 64 + d]) * w1[(size_t)(i * 64 + d) * 256 + n];
        }
        HID[((size_t)sel * (BATCH * NCMP * 2) + row) * 256 + n] = acc / (1.0f + __expf(-acc));
    }
    for (int it = gw; it < BATCH * 8 * 8; it += NGW) {
        const int h = it & 7, nbk = (it >> 3) & 7, b = it >> 6;
        const f16* x = (const f16*)Z1 + ((size_t)b * SEQ + nbk * 256) * N1 + Z1_KD + h * 64 + lane;
        float s = 0.f;
        for (int t = 0; t < 256; ++t) s += (float)x[(size_t)t * N1];
        KMEAN[(size_t)it * 64 + lane] = s * (1.0f / 256.f);
    }
}
__device__ __forceinline__ void l1_compress_out(const float* HID, const float* wk2, const float* wv2, float* KCMP, float* VCMP, int gw, int NGW, int lane) {
    const int nrows = BATCH * NCMP * 2;
    for (int it = gw; it < 2 * nrows; it += NGW) {
        const int sel = it / nrows, row = it % nrows;
        const float* h = HID + ((size_t)sel * nrows + row) * 256; const float* w2 = sel ? wv2 : wk2;
        float acc = 0.f;
        for (int n = 0; n < 256; ++n) acc += h[n] * w2[n * 64 + lane];
        (sel ? VCMP : KCMP)[(size_t)row * 64 + lane] = acc;
    }
}
__device__ __forceinline__ void l1_cmp_attn(const u16* Z1, const float* KCMP, const float* VCMP, float* OCMP, float* IMP, int wave, int lane) {
    for (int tb = blockIdx.x; tb < M / 64; tb += gridDim.x) {
        const int token = tb * 64 + lane, b = token / SEQ, qpos = token % SEQ, qmin = (tb * 64) % SEQ, head = wave, hkv = head >> 2;
        float q[64], o[64];
        load_q<64>(q, (const f16*)Z1 + (size_t)token * N1 + Z1_QC + head * 64, 0, 8);
#pragma unroll
        for (int d = 0; d < 64; ++d) o[d] = 0.f;
        const int cmax = qpos >= 31 ? (qpos - 31) >> 4 : -1;
        const int cmaxw = (qmin + 63 - 31) >> 4;
        const float* kc = KCMP + ((size_t)b * NCMP * 2 + hkv) * 64; const float* vc = VCMP + ((size_t)b * NCMP * 2 + hkv) * 64;
        float m = NEG, l = 0.f;
        for (int c = 0; c <= cmaxw && c < NCMP; ++c) {
            const float* kr = kc + (size_t)c * 128; float s = 0.f;
#pragma unroll
            for (int d = 0; d < 64; ++d) s += q[d] * kr[d];
            if (c <= cmax) { const float mn = fmaxf(m, s), a = __builtin_amdgcn_exp2f(m - mn), p = __builtin_amdgcn_exp2f(s - mn); m = mn; l = l * a + p;
                const float* vr = vc + (size_t)c * 128;
#pragma unroll
                for (int d = 0; d < 64; ++d) o[d] = o[d] * a + p * vr[d]; }
        }
        const float inv = l > 0.f ? 1.0f / l : 0.f;
        float* op = OCMP + (size_t)token * 512 + head * 64;
#pragma unroll
        for (int d = 0; d < 64; d += 4) *(f32x4*)(op + d) = (f32x4){o[d] * inv, o[d + 1] * inv, o[d + 2] * inv, o[d + 3] * inv};
        float* ip = IMP + ((size_t)token * 8 + head) * 32;
        for (int j = 0; j < 32; ++j) {
            float acc = 0.f;
            if (4 * j - 1 <= cmaxw) {
#pragma unroll
                for (int cc = -1; cc < 4; ++cc) { const int c = 4 * j + cc;
                    if (c >= 0 && c < NCMP && c <= cmaxw) { const float* kr = kc + (size_t)c * 128; float s = 0.f;
#pragma unroll
                        for (int d = 0; d < 64; ++d) s += q[d] * kr[d];
                        if (c <= cmax) acc += __builtin_amdgcn_exp2f(s - m) * inv; } }
            }
            ip[j] = acc;
        }
    }
}
__device__ __forceinline__ void l1_select(const u16* Z1, const float* IMP, const float* KMEAN, unsigned* SEL, unsigned* MSEL, int gtid, int NT) {
    for (int r = gtid; r < M * 2; r += NT) {
        const int token = r >> 1, hkv = r & 1, qpos = token % SEQ, cur = qpos >> 6;
        float v[32];
#pragma unroll
        for (int j = 0; j < 32; ++j) v[j] = 0.f;
#pragma unroll
        for (int g = 0; g < 4; ++g) { const f32x4* ip = (const f32x4*)(IMP + ((size_t)token * 8 + hkv * 4 + g) * 32);
#pragma unroll
            for (int j4 = 0; j4 < 8; ++j4) { const f32x4 t = ip[j4]; v[4 * j4] += t.x; v[4 * j4 + 1] += t.y; v[4 * j4 + 2] += t.z; v[4 * j4 + 3] += t.w; } }
#pragma unroll
        for (int j = 0; j < 32; ++j) { const bool forced = (j == 0) || (j == cur) || (j == cur - 1); v[j] = forced ? 1e9f : (j <= cur ? v[j] : NEG); }
        unsigned mask = 0u;
#pragma unroll
        for (int r8 = 0; r8 < 8; ++r8) { float best = NEG; int bi = -1;
#pragma unroll
            for (int j = 0; j < 32; ++j) { const bool free_ = !((mask >> j) & 1u); if (free_ && v[j] > best) { best = v[j]; bi = j; } }
            if (bi >= 0) mask |= 1u << bi; }
        SEL[r] = mask;
    }
    for (int r = gtid; r < M * 8; r += NT) {
        const int token = r >> 3, h = r & 7, b = token / SEQ, qpos = token % SEQ, cur = qpos >> 8;
        float q[64];
        load_q<64>(q, (const f16*)Z1 + (size_t)token * N1 + Z1_QD + h * 64, 0, 8);
        float gte[8];
#pragma unroll
        for (int n = 0; n < 8; ++n) { gte[n] = NEG;
            if (n < cur) { const float* km = KMEAN + (((size_t)b * 8 + n) * 8 + h) * 64; float s = 0.f;
#pragma unroll
                for (int d = 0; d < 64; ++d) s += q[d] * km[d];
                gte[n] = s; } }
        unsigned mask = 0u;
#pragma unroll
        for (int r3 = 0; r3 < 3; ++r3) { float best = NEG; int bi = -1;
#pragma unroll
            for (int n = 0; n < 8; ++n) { const bool free_ = !((mask >> n) & 1u); if (free_ && gte[n] > best) { best = gte[n]; bi = n; } }
            if (bi >= 0) mask |= 1u << bi; }
        MSEL[r] = mask;
    }
}
__device__ __forceinline__ void l1_attn_naive(const u16* Z1, const float* bias, const unsigned* SEL, const unsigned* MSEL, float* OCMP, u16* O, int wave, int lane) {
    for (int tb = blockIdx.x; tb < M / 64; tb += gridDim.x) {
        const int token = tb * 64 + lane, b = token / SEQ, qpos = token % SEQ, qmin = (tb * 64) % SEQ, head = wave, hkv = head >> 2;
        const f16* zb = (const f16*)Z1 + (size_t)b * SEQ * N1;
        const f16* zt = (const f16*)Z1 + (size_t)token * N1;
        float q[64], o[64];
        load_q<64>(q, zt + Z1_QC + head * 64, 0, 8);
        const float* bt = bias + (8 + head) * 2048;
        float* oc = OCMP + (size_t)token * 512 + head * 64;
#pragma unroll
        for (int d = 0; d < 64; ++d) o[d] = 0.f;
        float m = NEG, l = 0.f;
        const unsigned sel = SEL[token * 2 + hkv];
        const KeyZ kf{zb + Z1_KS + hkv * 64, zb + Z1_VS + hkv * 64, N1};
        auto sf = [&](int kp, float& s) -> bool { const int d = qpos - kp; if (d < 0 || !((sel >> (kp >> 6)) & 1u)) return false; s += bt[d]; return true; };
        naive_attend<64>(q, m, l, o, 0, qmin + 63, kf, sf);
        const float g0 = 1.0f / (1.0f + __expf(-(float)zt[Z1_GL + head])), g1 = 1.0f / (1.0f + __expf(-(float)zt[Z1_GL + 8 + head]));
        const float inv = g1 / l;
#pragma unroll
        for (int d = 0; d < 64; d += 4) { f32x4 t = *(f32x4*)(oc + d); t = t * g0 + (f32x4){o[d] * inv, o[d + 1] * inv, o[d + 2] * inv, o[d + 3] * inv}; *(f32x4*)(oc + d) = t; }
    }
    for (int tb = blockIdx.x; tb < M / 64; tb += gridDim.x) {
        const int token = tb * 64 + lane, b = token / SEQ, qpos = token % SEQ, qmin = (tb * 64) % SEQ, head = wave, hkv = head >> 2;
        const f16* zb = (const f16*)Z1 + (size_t)b * SEQ * N1;
        const f16* zt = (const f16*)Z1 + (size_t)token * N1;
        float q[64], o[64];
        load_q<64>(q, zt + Z1_QC + head * 64, 0, 8);
        const float* bt = bias + (8 + head) * 2048;
        const float* oc = OCMP + (size_t)token * 512 + head * 64;
#pragma unroll
        for (int d = 0; d < 64; ++d) o[d] = 0.f;
        float m = NEG, l = 0.f;
        const KeyZ kf{zb + Z1_KW + hkv * 64, zb + Z1_VW + hkv * 64, N1};
        auto sf = [&](int kp, float& s) -> bool { const int d = qpos - kp; if (d < 0 || d >= 256) return false; s += bt[d]; return true; };
        const int klo = qmin - 255 < 0 ? 0 : qmin - 255;
        naive_attend<64>(q, m, l, o, klo, qmin + 63, kf, sf);
        const float g2 = 1.0f / (1.0f + __expf(-(float)zt[Z1_GL + 16 + head]));
        const float inv = g2 / l;
#pragma unroll
        for (int d = 0; d < 64; d += 4) { const f32x4 t = *(const f32x4*)(oc + d); o[d] = t.x + o[d] * inv; o[d + 1] = t.y + o[d + 1] * inv; o[d + 2] = t.z + o[d + 2] * inv; o[d + 3] = t.w + o[d + 3] * inv; }
        store_o64(O + (size_t)token * DM + head * 64, o, 1.0f);
    }
    for (int tb = blockIdx.x; tb < M / 64; tb += gridDim.x) {
        const int token = tb * 64 + lane, b = token / SEQ, qpos = token % SEQ, qmin = (tb * 64) % SEQ, head = wave;
        const f16* zb = (const f16*)Z1 + (size_t)b * SEQ * N1;
        const f16* zt = (const f16*)Z1 + (size_t)token * N1;
        float q[64], o[64];
        load_q<64>(q, zt + Z1_QD + head * 64, 0, 8);
#pragma unroll
        for (int d = 0; d < 64; ++d) o[d] = 0.f;
        float m = NEG, l = 0.f;
        const unsigned msel = MSEL[token * 8 + head]; const int cur = qpos >> 8;
        const float* bt = bias + (16 + head) * 2048;
        const KeyZ kf{zb + Z1_KD + head * 64, zb + Z1_VD + head * 64, N1};
        auto sf = [&](int kp, float& s) -> bool { const int d = qpos - kp; const int kb = kp >> 8; if (d < 0 || !(kb == cur || ((msel >> kb) & 1u))) return false; s += bt[d]; return true; };
        naive_attend<64>(q, m, l, o, 0, qmin + 63, kf, sf);
        store_o64(O + (size_t)token * DM + 512 + head * 64, o, 1.0f / l);
    }
}

namespace att {
typedef float f32x16 __attribute__((ext_vector_type(16)));
typedef short s16x4 __attribute__((ext_vector_type(4)));
enum { AT_A = 0, AT_B = 1, AT_SLC = 2, AT_WIN = 3, AT_D = 4 };
constexpr int PVB = 192;
constexpr int KB_OFF = 0, KB_STRIDE = 13312, VB_OFF = 26624, VB_STRIDE = 12288;
constexpr int BT_OFF = 51200, BT_PAD = 128, BT_HEAD = BT_PAD + 2048;
constexpr int RED_OFF = BT_OFF + 8 * BT_HEAD * 4;
static_assert(RED_OFF + 64 <= RING_BYTES, "attention LDS map");
constexpr float MINIT = -1e20f;

__device__ __forceinline__ void build_bias(LAS unsigned char* lds, const float* bias, int slot0, int tid) {
    LAS float* bt = (LAS float*)(lds + BT_OFF);
    for (int i = tid; i < 8 * BT_HEAD; i += NTHREADS) { const int h = i / BT_HEAD, d = i % BT_HEAD - BT_PAD; bt[i] = d >= 0 ? bias[(slot0 + h) * 2048 + d] : 0.f; }
}

struct TileRegs { u32x4 k0, k1, v; };
template <int DQK> __device__ __forceinline__ void tile_load(TileRegs& R, const f16* Kg, int kpitch, const f16* K2g, const f16* Vg, int vpitch, int t, int tid) {
    const int row = 64 * t + (tid >> 3), ch = tid & 7;
    R.k0 = *(const u32x4*)(Kg + (size_t)row * kpitch + ch * 8);
    if constexpr (DQK == 96) { if (tid < 256) R.k1 = *(const u32x4*)(K2g + (size_t)(64 * t + (tid >> 2)) * 32 + (tid & 3) * 8); }
    R.v = *(const u32x4*)(Vg + (size_t)row * vpitch + ch * 8);
}
template <int DQK> __device__ __forceinline__ void tile_store(const TileRegs& R, LAS unsigned char* kbuf, LAS unsigned char* vbuf, int tid) {
    constexpr int PK = DQK == 96 ? 208 : 144;
    const int row = tid >> 3, ch = tid & 7;
    *(LAS u32x4*)(kbuf + row * PK + ch * 16) = R.k0;
    if constexpr (DQK == 96) { if (tid < 256) *(LAS u32x4*)(kbuf + (tid >> 2) * PK + 128 + (tid & 3) * 16) = R.k1; }
    *(LAS u32x4*)(vbuf + row * PVB + ch * 16) = R.v;
}
__device__ __forceinline__ f16x8 tr_pair(const LAS unsigned char* p) {
    const s16x4 lo = __builtin_amdgcn_ds_read_tr16_b64_v4i16((LAS s16x4*)p);
    const s16x4 hi = __builtin_amdgcn_ds_read_tr16_b64_v4i16((LAS s16x4*)(p + 4 * PVB));
    typedef short s16x8 __attribute__((ext_vector_type(8)));
    const s16x8 v = __builtin_shufflevector(lo, hi, 0, 1, 2, 3, 4, 5, 6, 7);
    return __builtin_bit_cast(f16x8, v);
}

template <int MODE, int DQK>
__device__ __forceinline__ void attn_tiles(LAS unsigned char* lds, const f16* Kg, int kpitch, const f16* K2g, const f16* Vg, int vpitch,
        const f16x8 (&qf)[DQK / 16], int qpos, int wq_lo, unsigned tilemask, unsigned rowsel, int cur_blk, const LAS float* bt,
        float& m, float& l, f32x16 (&oacc)[2], int tid, int lane) {
    constexpr int PK = DQK == 96 ? 208 : 144;
    constexpr bool HAS_BIAS = MODE != AT_B;
    constexpr int W = MODE == AT_A ? 128 : (MODE == AT_WIN ? 256 : (1 << 30));
    if (!tilemask) return;
    const int hi = lane >> 5, r32 = lane & 31;
    const int pirow = (r32 & 19) | ((r32 & 4) << 1) | ((r32 & 8) >> 1);
    const int g4 = lane >> 4, lg = lane & 15;
    const unsigned kfoff = pirow * PK + hi * 16;
    const unsigned vfoff = (8 * (g4 >> 1) + (lg >> 2)) * PVB + (16 * (g4 & 1) + 4 * (lg & 3)) * 2;
    const int wq_hi = wq_lo + 31;
    unsigned rem = tilemask; int t = __builtin_ctz(rem); rem &= rem - 1;
    TileRegs R;
    tile_load<DQK>(R, Kg, kpitch, K2g, Vg, vpitch, t, tid);
    tile_store<DQK>(R, lds + KB_OFF, lds + VB_OFF, tid);
    __syncthreads();
    int cb = 0;
    for (;;) {
        int tn = -1;
        if (rem) { tn = __builtin_ctz(rem); rem &= rem - 1; tile_load<DQK>(R, Kg, kpitch, K2g, Vg, vpitch, tn, tid); }
        const int k0 = 64 * t;
        bool live = (k0 <= wq_hi) && (wq_lo - (k0 + 63) < W);
        bool rok = true;
        if constexpr (MODE == AT_SLC) rok = (rowsel >> t) & 1u;
        if constexpr (MODE == AT_D) rok = ((t >> 2) == cur_blk) || ((rowsel >> (t >> 2)) & 1u);
        if constexpr (MODE == AT_SLC || MODE == AT_D) live = live && (__builtin_amdgcn_ballot_w64(rok) != 0ull);
        if (live) {
            const LAS unsigned char* kb = lds + KB_OFF + cb * KB_STRIDE + kfoff;
            const LAS unsigned char* vb = lds + VB_OFF + cb * VB_STRIDE + vfoff;
            f32x16 p0, p1;
#pragma unroll
            for (int r = 0; r < 16; ++r) { p0[r] = 0.f; p1[r] = 0.f; }
#pragma unroll
            for (int d0 = 0; d0 < DQK / 16; ++d0) {
                const f16x8 ka = *(const LAS f16x8*)(kb + d0 * 32);
                const f16x8 kc = *(const LAS f16x8*)(kb + 32 * PK + d0 * 32);
                p0 = __builtin_amdgcn_mfma_f32_32x32x16_f16(ka, qf[d0], p0, 0, 0, 0);
                p1 = __builtin_amdgcn_mfma_f32_32x32x16_f16(kc, qf[d0], p1, 0, 0, 0);
            }
            const int dq = qpos - k0 - 8 * hi;
            if constexpr (HAS_BIAS) {
                const LAS float* bp = bt + (dq - 55);
#pragma unroll
                for (int r = 0; r < 16; ++r) { p0[r] += bp[55 - (16 * (r >> 3) + (r & 7))]; p1[r] += bp[55 - (32 + 16 * (r >> 3) + (r & 7))]; }
            }
            const bool emask = (k0 + 63 > wq_lo) || (wq_hi - k0 >= W);
            if (emask) {
#pragma unroll
                for (int r = 0; r < 16; ++r) { const int d0_ = dq - (16 * (r >> 3) + (r & 7)), d1_ = d0_ - 32;
                    p0[r] = (d0_ >= 0 && d0_ < W) ? p0[r] : NEG; p1[r] = (d1_ >= 0 && d1_ < W) ? p1[r] : NEG; }
            }
            if constexpr (MODE == AT_SLC || MODE == AT_D) {
                if (!rok) {
#pragma unroll
                    for (int r = 0; r < 16; ++r) { p0[r] = NEG; p1[r] = NEG; } }
            }
            float mx = fmaxf(p0[0], p1[0]);
#pragma unroll
            for (int r = 1; r < 16; ++r) mx = fmaxf(mx, fmaxf(p0[r], p1[r]));
            mx = fmaxf(mx, __shfl_xor(mx, 32));
            const float mn = fmaxf(m, mx), alpha = __builtin_amdgcn_exp2f(m - mn);
            m = mn;
            float ps = 0.f;
#pragma unroll
            for (int r = 0; r < 16; ++r) { p0[r] = __builtin_amdgcn_exp2f(p0[r] - mn); p1[r] = __builtin_amdgcn_exp2f(p1[r] - mn); ps += p0[r] + p1[r]; }
            l = l * alpha + ps;
#pragma unroll
            for (int r = 0; r < 16; ++r) { oacc[0][r] *= alpha; oacc[1][r] *= alpha; }
            f16x8 pf[4];
#pragma unroll
            for (int j = 0; j < 8; ++j) { pf[0][j] = (f16)p0[j]; pf[1][j] = (f16)p0[8 + j]; pf[2][j] = (f16)p1[j]; pf[3][j] = (f16)p1[8 + j]; }
#pragma unroll
            for (int ks = 0; ks < 4; ++ks)
#pragma unroll
                for (int dt = 0; dt < 2; ++dt) {
                    const f16x8 vf = tr_pair(vb + ks * 16 * PVB + dt * 64);
                    oacc[dt] = __builtin_amdgcn_mfma_f32_32x32x16_f16(vf, pf[ks], oacc[dt], 0, 0, 0);
                }
        }
        if (tn >= 0) tile_store<DQK>(R, lds + KB_OFF + (cb ^ 1) * KB_STRIDE, lds + VB_OFF + (cb ^ 1) * VB_STRIDE, tid);
        __syncthreads();
        if (tn < 0) break;
        t = tn; cb ^= 1;
    }
}
__device__ __forceinline__ void store_ot(u16* orow, const f32x16 (&o)[2], int hi) {
#pragma unroll
    for (int dt = 0; dt < 2; ++dt)
#pragma unroll
        for (int a = 0; a < 4; ++a) { u32x2 w; w.x = pg8::pk_f16(o[dt][4 * a], o[dt][4 * a + 1]); w.y = pg8::pk_f16(o[dt][4 * a + 2], o[dt][4 * a + 3]);
            *(u32x2*)(orow + 32 * dt + 8 * a + 4 * hi) = w; }
}
template <int NF> __device__ __forceinline__ void load_qf(f16x8 (&qf)[NF], const f16* qrow, int hi) {
#pragma unroll
    for (int d0 = 0; d0 < NF; ++d0) qf[d0] = *(const f16x8*)(qrow + 16 * d0 + 8 * hi);
}
__device__ __forceinline__ void zero_o(f32x16 (&o)[2]) {
#pragma unroll
    for (int r = 0; r < 16; ++r) { o[0][r] = 0.f; o[1][r] = 0.f; }
}
__device__ __forceinline__ int snake(int i, int G, int c) { return i * G + ((i & 1) ? (G - 1 - c) : c); }
__device__ __forceinline__ unsigned wg_or(LAS unsigned char* lds, unsigned v, int wave, int lane) {
#pragma unroll
    for (int o = 1; o < 64; o <<= 1) v |= __shfl_xor(v, o);
    LAS unsigned* red = (LAS unsigned*)(lds + RED_OFF);
    if (lane == 0) red[wave] = v;
    __syncthreads();
    unsigned r = 0u;
#pragma unroll
    for (int w = 0; w < NWAVES; ++w) r |= red[w];
    __syncthreads();
    return r;
}

__device__ __forceinline__ void l0_attn(LAS unsigned char* lds, const u16* Z0, const u16* QBp, const u16* KVBp, const u16* KRp, const float* bias, const f32x2* rope, const float* sinks, u16* O, int tid, int wave, int lane) {
    const int G = gridDim.x, c = blockIdx.x, hi = lane >> 5, r32 = lane & 31;
    build_bias(lds, bias, 0, tid);
    __syncthreads();
    for (int i = 0;; ++i) {
        const int u = snake(i, G, c); if (u >= 512) break;
        const int qt = 7 - (u >> 6), b = (u >> 3) & 7, h = u & 7, q0 = qt * 256;
        const int qpos = q0 + 32 * wave + r32; const size_t token = (size_t)b * SEQ + qpos;
        f16x8 qf[6];
        load_qf<6>(qf, (const f16*)QBp + token * 768 + h * 96, hi);
        {
#pragma unroll
            for (int j = 0; j < 8; ++j) { const f32x2 cs = rope[qpos * 16 + 8 * hi + j]; const float x1 = (float)qf[4][j], x2 = (float)qf[5][j];
                qf[4][j] = (f16)(x1 * cs.x - x2 * cs.y); qf[5][j] = (f16)(x2 * cs.x + x1 * cs.y); }
        }
        float m = MINIT, l = 0.f; f32x16 o[2]; zero_o(o);
        const int nt = (q0 >> 6) + 4; const unsigned tm = nt >= 32 ? 0xffffffffu : ((1u << nt) - 1u);
        attn_tiles<AT_B, 96>(lds, (const f16*)KVBp + (size_t)b * SEQ * 1024 + h * 128, 1024, (const f16*)KRp + (size_t)b * SEQ * 32, (const f16*)KVBp + (size_t)b * SEQ * 1024 + h * 128 + 64, 1024,
                             qf, qpos, q0 + 32 * wave, tm, 0u, 0, nullptr, m, l, o, tid, lane);
        l += __shfl_xor(l, 32);
        const float inv = 1.0f / l;
#pragma unroll
        for (int r = 0; r < 16; ++r) { o[0][r] *= inv; o[1][r] *= inv; }
        store_ot(O + token * DM + 512 + h * 64, o, hi);
    }
    for (int i = 0;; ++i) {
        const int u = i * G + c; if (u >= 512) break;
        const int qt = u >> 4, b = (u >> 1) & 7, hkv = u & 1, q0 = qt * 64, g = wave & 3, head = hkv * 4 + g;
        const int wq_lo = q0 + 32 * (wave >> 2), qpos = wq_lo + r32; const size_t token = (size_t)b * SEQ + qpos;
        f16x8 qf[4];
        load_qf<4>(qf, (const f16*)Z0 + token * N0 + Z0_QA + head * 64, hi);
        float m = fmaxf(sinks[head] * LOG2E, MINIT), l = hi == 0 ? 1.f : 0.f; f32x16 o[2]; zero_o(o);
        const int t1 = q0 >> 6, t0 = t1 - 2 < 0 ? 0 : t1 - 2; const unsigned tm = ((2u << t1) - 1u) & ~((1u << t0) - 1u);
        const f16* zb = (const f16*)Z0 + (size_t)b * SEQ * N0;
        attn_tiles<AT_A, 64>(lds, zb + Z0_KA + hkv * 64, N0, nullptr, zb + Z0_VA + hkv * 64, N0, qf, qpos, wq_lo, tm, 0u, 0,
                             (const LAS float*)(lds + BT_OFF) + head * BT_HEAD + BT_PAD, m, l, o, tid, lane);
        l += __shfl_xor(l, 32);
        const float inv = 1.0f / l;
#pragma unroll
        for (int r = 0; r < 16; ++r) { o[0][r] *= inv; o[1][r] *= inv; }
        store_ot(O + token * DM + head * 64, o, hi);
    }
}

__device__ __forceinline__ void l1_attn(LAS unsigned char* lds, const u16* Z1, const float* bias, const unsigned* SEL, const unsigned* MSEL, const float* OCMP, u16* O, int tid, int wave, int lane) {
    const int G = gridDim.x, c = blockIdx.x, hi = lane >> 5, r32 = lane & 31;
    build_bias(lds, bias, 8, tid);
    __syncthreads();
    for (int i = 0;; ++i) {
        const int u = snake(i, G, c); if (u >= 512) break;
        const int qt = 31 - (u >> 4), b = (u >> 1) & 7, hkv = u & 1, q0 = qt * 64, g = wave & 3, head = hkv * 4 + g;
        const int wq_lo = q0 + 32 * (wave >> 2), qpos = wq_lo + r32; const size_t token = (size_t)b * SEQ + qpos;
        const f16* zb = (const f16*)Z1 + (size_t)b * SEQ * N1; const f16* zt = (const f16*)Z1 + token * N1;
        f16x8 qf[4];
        load_qf<4>(qf, zt + Z1_QC + head * 64, hi);
        const LAS float* bt = (const LAS float*)(lds + BT_OFF) + head * BT_HEAD + BT_PAD;
        const unsigned sel = SEL[token * 2 + hkv];
        const unsigned tm_s = wg_or(lds, sel, wave, lane);
        f32x16 res[2];
        {
            float m = MINIT, l = 0.f; f32x16 o[2]; zero_o(o);
            attn_tiles<AT_SLC, 64>(lds, zb + Z1_KS + hkv * 64, N1, nullptr, zb + Z1_VS + hkv * 64, N1, qf, qpos, wq_lo, tm_s, sel, 0, bt, m, l, o, tid, lane);
            l += __shfl_xor(l, 32);
            const float g1 = 1.0f / (1.0f + __expf(-(float)zt[Z1_GL + 8 + head])); const float inv = g1 / l;
#pragma unroll
            for (int r = 0; r < 16; ++r) { res[0][r] = o[0][r] * inv; res[1][r] = o[1][r] * inv; }
        }
        {
            float m = MINIT, l = 0.f; f32x16 o[2]; zero_o(o);
            const int t1 = q0 >> 6, t0 = t1 - 4 < 0 ? 0 : t1 - 4; const unsigned tm = (t1 >= 31 ? 0xffffffffu : ((2u << t1) - 1u)) & ~((1u << t0) - 1u);
            attn_tiles<AT_WIN, 64>(lds, zb + Z1_KW + hkv * 64, N1, nullptr, zb + Z1_VW + hkv * 64, N1, qf, qpos, wq_lo, tm, 0u, 0, bt, m, l, o, tid, lane);
            l += __shfl_xor(l, 32);
            const float g2 = 1.0f / (1.0f + __expf(-(float)zt[Z1_GL + 16 + head])); const float inv = g2 / l;
#pragma unroll
            for (int r = 0; r < 16; ++r) { res[0][r] += o[0][r] * inv; res[1][r] += o[1][r] * inv; }
        }
        {
            const float g0 = 1.0f / (1.0f + __expf(-(float)zt[Z1_GL + head]));
            const float* oc = OCMP + token * 512 + head * 64;
#pragma unroll
            for (int dt = 0; dt < 2; ++dt)
#pragma unroll
                for (int a = 0; a < 4; ++a) { const f32x4 tq = *(const f32x4*)(oc + 32 * dt + 8 * a + 4 * hi);
                    res[dt][4 * a] += g0 * tq.x; res[dt][4 * a + 1] += g0 * tq.y; res[dt][4 * a + 2] += g0 * tq.z; res[dt][4 * a + 3] += g0 * tq.w; }
        }
        store_ot(O + token * DM + head * 64, res, hi);
    }
    __syncthreads();
    build_bias(lds, bias, 16, tid);
    __syncthreads();
    for (int i = 0;; ++i) {
        const int u = snake(i, G, c); if (u >= 512) break;
        const int qt = 7 - (u >> 6), b = (u >> 3) & 7, h = u & 7, q0 = qt * 256;
        const int wq_lo = q0 + 32 * wave, qpos = wq_lo + r32; const size_t token = (size_t)b * SEQ + qpos;
        const f16* zb = (const f16*)Z1 + (size_t)b * SEQ * N1; const f16* zt = (const f16*)Z1 + token * N1;
        f16x8 qf[4];
        load_qf<4>(qf, zt + Z1_QD + h * 64, hi);
        const unsigned msel = MSEL[token * 8 + h];
        const unsigned um = wg_or(lds, msel, wave, lane) | (1u << qt);
        unsigned tm = 0u;
#pragma unroll
        for (int n = 0; n < 8; ++n) if ((um >> n) & 1u) tm |= 0xfu << (4 * n);
        float m = MINIT, l = 0.f; f32x16 o[2]; zero_o(o);
        attn_tiles<AT_D, 64>(lds, zb + Z1_KD + h * 64, N1, nullptr, zb + Z1_VD + h * 64, N1, qf, qpos, wq_lo, tm, msel, qt,
                             (const LAS float*)(lds + BT_OFF) + h * BT_HEAD + BT_PAD, m, l, o, tid, lane);
        l += __shfl_xor(l, 32);
        const float inv = 1.0f / l;
#pragma unroll
        for (int r = 0; r < 16; ++r) { o[0][r] *= inv; o[1][r] *= inv; }
        store_ot(O + token * DM + 512 + h * 64, o, hi);
    }
}
__device__ __forceinline__ void l1_compress_hidden(LAS unsigned char* lds, const u16* Z1, const u16* W1T, const float* PEB, float* HID, float* KMEAN, int tid, int wave, int lane, int gw, int NGW) {
    const int hi = lane >> 5, r32 = lane & 31;
    for (int job = blockIdx.x; job < 256; job += gridDim.x) {
        const int nh = job & 1, ctile = (job >> 1) & 3, bh = (job >> 3) & 15, sel = job >> 7, b = bh >> 1, hkv = bh & 1;
        int c = 32 * ctile + r32; if (c > NCMP - 1) c = NCMP - 1;
        const f16* xa = (const f16*)Z1 + ((size_t)b * SEQ + 16 * c + 4 * wave) * N1 + (sel ? Z1_VC : Z1_KC) + hkv * 64 + 8 * hi;
        const f16* wb = (const f16*)W1T + ((size_t)sel * 256 + nh * 128 + r32) * 2048 + 256 * wave + 8 * hi;
        f32x16 acc[4];
#pragma unroll
        for (int nt = 0; nt < 4; ++nt)
#pragma unroll
            for (int r = 0; r < 16; ++r) acc[nt][r] = 0.f;
#pragma unroll 4
        for (int ks = 0; ks < 16; ++ks) {
            const f16x8 af = *(const f16x8*)(xa + (size_t)(ks >> 2) * N1 + 16 * (ks & 3));
#pragma unroll
            for (int nt = 0; nt < 4; ++nt) { const f16x8 bf = *(const f16x8*)(wb + (size_t)nt * 32 * 2048 + 16 * ks); acc[nt] = __builtin_amdgcn_mfma_f32_32x32x16_f16(af, bf, acc[nt], 0, 0, 0); }
        }
        LAS float* part = (LAS float*)lds + wave * 4096;
#pragma unroll
        for (int nt = 0; nt < 4; ++nt)
#pragma unroll
            for (int r = 0; r < 16; ++r) part[((r & 3) + 8 * (r >> 2) + 4 * hi) * 128 + 32 * nt + r32] = acc[nt][r];
        __syncthreads();
#pragma unroll
        for (int k = 0; k < 8; ++k) { const int idx = tid + 512 * k, cc = idx >> 7, n = idx & 127; float sum = PEB[sel * 256 + nh * 128 + n];
#pragma unroll
            for (int w = 0; w < 8; ++w) sum += ((const LAS float*)lds)[w * 4096 + idx];
            const int cg = 32 * ctile + cc;
            if (cg < NCMP) HID[((size_t)sel * (BATCH * NCMP * 2) + ((size_t)b * NCMP + cg) * 2 + hkv) * 256 + nh * 128 + n] = sum / (1.0f + __expf(-sum)); }
        __syncthreads();
    }
    for (int it = gw; it < BATCH * 8 * 8; it += NGW) {
        const int h = it & 7, nbk = (it >> 3) & 7, b = it >> 6;
        const f16* x = (const f16*)Z1 + ((size_t)b * SEQ + nbk * 256) * N1 + Z1_KD + h * 64 + lane;
        float sacc = 0.f;
        for (int t = 0; t < 256; ++t) sacc += (float)x[(size_t)t * N1];
        KMEAN[(size_t)it * 64 + lane] = sacc * (1.0f / 256.f);
    }
}
constexpr int CK_OFF = 0, CV_OFF = 18432, CP_OFF = 43008;
__device__ __forceinline__ void l1_cmp_attn(LAS unsigned char* lds, const u16* Z1, const float* KCMP, const float* VCMP, float* OCMP, unsigned* SEL, int tid, int wave, int lane) {
    const int hi = lane >> 5, r32 = lane & 31;
    const int pirow = (r32 & 19) | ((r32 & 4) << 1) | ((r32 & 8) >> 1);
    const int g4 = lane >> 4, lg = lane & 15;
    const unsigned kfoff = pirow * 144 + hi * 16;
    const unsigned vfoff = (8 * (g4 >> 1) + (lg >> 2)) * PVB + (16 * (g4 & 1) + 4 * (lg & 3)) * 2;
    for (int unit = blockIdx.x; unit < 256; unit += gridDim.x) {
        const int qt = unit >> 4, b = (unit >> 1) & 7, hkv = unit & 1, q0 = 128 * qt;
        {
            const int row = tid >> 2, col = (tid & 3) * 16;
            f32x4 kv[4], vv[4];
#pragma unroll
            for (int x = 0; x < 4; ++x) { kv[x] = (f32x4){0.f, 0.f, 0.f, 0.f}; vv[x] = kv[x]; }
            if (row < NCMP) { const size_t off = (((size_t)b * NCMP + row) * 2 + hkv) * 64 + col;
#pragma unroll
                for (int x = 0; x < 4; ++x) { kv[x] = *(const f32x4*)(KCMP + off + 4 * x); vv[x] = *(const f32x4*)(VCMP + off + 4 * x); } }
#pragma unroll
            for (int x = 0; x < 2; ++x) {
                u32x4 w; w.x = pg8::pk_f16(kv[2 * x].x, kv[2 * x].y); w.y = pg8::pk_f16(kv[2 * x].z, kv[2 * x].w); w.z = pg8::pk_f16(kv[2 * x + 1].x, kv[2 * x + 1].y); w.w = pg8::pk_f16(kv[2 * x + 1].z, kv[2 * x + 1].w);
                *(LAS u32x4*)(lds + CK_OFF + row * 144 + col * 2 + 16 * x) = w;
                u32x4 y; y.x = pg8::pk_f16(vv[2 * x].x, vv[2 * x].y); y.y = pg8::pk_f16(vv[2 * x].z, vv[2 * x].w); y.z = pg8::pk_f16(vv[2 * x + 1].x, vv[2 * x + 1].y); y.w = pg8::pk_f16(vv[2 * x + 1].z, vv[2 * x + 1].w);
                *(LAS u32x4*)(lds + CV_OFF + row * PVB + col * 2 + 16 * x) = y; }
        }
        __syncthreads();
        const int qg = wave & 3, hp = wave >> 2, wq_lo = q0 + 32 * qg, qpos = wq_lo + r32; const size_t token = (size_t)b * SEQ + qpos;
        const int cmax = qpos >= 31 ? (qpos - 31) >> 4 : -1;
        const int nsub = ((wq_lo >> 4) >> 5) + 1;
        float part[24];
#pragma unroll
        for (int x = 0; x < 24; ++x) part[x] = 0.f;
#pragma unroll
        for (int gg = 0; gg < 2; ++gg) {
            const int head = hkv * 4 + 2 * hp + gg;
            f16x8 qf[4];
            load_qf<4>(qf, (const f16*)Z1 + token * N1 + Z1_QC + head * 64, hi);
            f32x16 sc[4];
#pragma unroll
            for (int sub = 0; sub < 4; ++sub) {
#pragma unroll
                for (int r = 0; r < 16; ++r) sc[sub][r] = 0.f;
                if (sub < nsub) {
#pragma unroll
                    for (int d0 = 0; d0 < 4; ++d0) { const f16x8 ka = *(const LAS f16x8*)(lds + CK_OFF + kfoff + sub * 32 * 144 + d0 * 32);
                        sc[sub] = __builtin_amdgcn_mfma_f32_32x32x16_f16(ka, qf[d0], sc[sub], 0, 0, 0); }
                }
#pragma unroll
                for (int r = 0; r < 16; ++r) { const int cidx = 32 * sub + 16 * (r >> 3) + 8 * hi + (r & 7); sc[sub][r] = (sub < nsub && cidx <= cmax) ? sc[sub][r] : NEG; }
            }
            float mx = MINIT;
#pragma unroll
            for (int sub = 0; sub < 4; ++sub)
#pragma unroll
                for (int r = 0; r < 16; ++r) mx = fmaxf(mx, sc[sub][r]);
            mx = fmaxf(mx, __shfl_xor(mx, 32));
            float ps = 0.f;
#pragma unroll
            for (int sub = 0; sub < 4; ++sub)
#pragma unroll
                for (int r = 0; r < 16; ++r) { sc[sub][r] = __builtin_amdgcn_exp2f(sc[sub][r] - mx); ps += sc[sub][r]; }
            ps += __shfl_xor(ps, 32);
            const float inv = ps > 0.f ? 1.0f / ps : 0.f;
#pragma unroll
            for (int sub = 0; sub < 4; ++sub)
#pragma unroll
                for (int r = 0; r < 16; ++r) sc[sub][r] *= inv;
            f32x16 o[2]; zero_o(o);
#pragma unroll
            for (int sub = 0; sub < 4; ++sub) {
                if (sub < nsub) {
#pragma unroll
                    for (int a = 0; a < 2; ++a) { f16x8 pf;
#pragma unroll
                        for (int j = 0; j < 8; ++j) pf[j] = (f16)sc[sub][8 * a + j];
#pragma unroll
                        for (int dt = 0; dt < 2; ++dt) { const f16x8 vf = tr_pair(lds + CV_OFF + vfoff + (2 * sub + a) * 16 * PVB + dt * 64); o[dt] = __builtin_amdgcn_mfma_f32_32x32x16_f16(vf, pf, o[dt], 0, 0, 0); } }
                }
#pragma unroll
                for (int a = 0; a < 2; ++a) { const int x = (sub * 2 + a) * 3; const float p3 = sc[sub][8 * a + 3], p7 = sc[sub][8 * a + 7];
                    part[x] += (sc[sub][8 * a] + sc[sub][8 * a + 1]) + (sc[sub][8 * a + 2] + p3);
                    part[x + 1] += (p3 + sc[sub][8 * a + 4]) + (sc[sub][8 * a + 5] + sc[sub][8 * a + 6]) + p7;
                    part[x + 2] += p7; }
            }
            float* op = OCMP + token * 512 + head * 64;
#pragma unroll
            for (int dt = 0; dt < 2; ++dt)
#pragma unroll
                for (int a = 0; a < 4; ++a) *(f32x4*)(op + 32 * dt + 8 * a + 4 * hi) = (f32x4){o[dt][4 * a], o[dt][4 * a + 1], o[dt][4 * a + 2], o[dt][4 * a + 3]};
        }
        {
            LAS float* pp = (LAS float*)(lds + CP_OFF) + ((wave * 32 + r32) * 2 + hi) * 24;
#pragma unroll
            for (int x = 0; x < 24; ++x) pp[x] = part[x];
        }
        __syncthreads();
        if (tid < 128) {
            const int qg2 = tid >> 5, rr = tid & 31, qp = q0 + tid, cur = qp >> 6;
            float v[32];
#pragma unroll
            for (int j = 0; j < 32; ++j) v[j] = 0.f;
#pragma unroll
            for (int hp2 = 0; hp2 < 2; ++hp2)
#pragma unroll
                for (int h2 = 0; h2 < 2; ++h2) { const LAS float* pp = (const LAS float*)(lds + CP_OFF) + (((hp2 * 4 + qg2) * 32 + rr) * 2 + h2) * 24;
#pragma unroll
                    for (int sa = 0; sa < 8; ++sa) { const int J0 = 4 * sa + 2 * h2;
                        v[J0] += pp[sa * 3]; v[J0 + 1] += pp[sa * 3 + 1]; if (J0 + 2 < 32) v[J0 + 2] += pp[sa * 3 + 2]; } }
#pragma unroll
            for (int j = 0; j < 32; ++j) { const bool forced = (j == 0) || (j == cur) || (j == cur - 1); v[j] = forced ? 1e9f : (j <= cur ? v[j] : NEG); }
            unsigned mask = 0u;
#pragma unroll
            for (int r8 = 0; r8 < 8; ++r8) { float best = NEG; int bi = -1;
#pragma unroll
                for (int j = 0; j < 32; ++j) { const bool free_ = !((mask >> j) & 1u); if (free_ && v[j] > best) { best = v[j]; bi = j; } }
                if (bi >= 0) mask |= 1u << bi; }
            SEL[((size_t)b * SEQ + qp) * 2 + hkv] = mask;
        }
        __syncthreads();
    }
}
__device__ __forceinline__ void l1_moba_select(const u16* Z1, const float* KMEAN, unsigned* MSEL, int gtid, int NT) {
    for (int r = gtid; r < M * 8; r += NT) {
        const int token = r >> 3, h = r & 7, b = token / SEQ, qpos = token % SEQ, cur = qpos >> 8;
        float q[64];
        load_q<64>(q, (const f16*)Z1 + (size_t)token * N1 + Z1_QD + h * 64, 0, 8);
        float gte[8];
#pragma unroll
        for (int n = 0; n < 8; ++n) { gte[n] = NEG;
            if (n < cur) { const float* km = KMEAN + (((size_t)b * 8 + n) * 8 + h) * 64; float sacc = 0.f;
#pragma unroll
                for (int d = 0; d < 64; ++d) sacc += q[d] * km[d];
                gte[n] = sacc; } }
        unsigned mask = 0u;
#pragma unroll
        for (int r3 = 0; r3 < 3; ++r3) { float best = NEG; int bi = -1;
#pragma unroll
            for (int n = 0; n < 8; ++n) { const bool free_ = !((mask >> n) & 1u); if (free_ && gte[n] > best) { best = gte[n]; bi = n; } }
            if (bi >= 0) mask |= 1u << bi; }
        MSEL[r] = mask;
    }
}
}

struct Args { const float* in[41]; float* out; unsigned char* ws; int ph_lo, ph_hi; };
enum { I_X = 0, I_REL = 1, I_L0 = 2, I_L1 = 21 };

__global__ void __launch_bounds__(NTHREADS, 2) fwd(Args args) {
    extern __shared__ __attribute__((aligned(16))) unsigned char lds_raw[];
    LAS unsigned char* lds = (LAS unsigned char*)lds_raw;
    volatile LAS unsigned* MISC = (volatile LAS unsigned*)(lds + MISC_OFF);
    const int tid = threadIdx.x, lane = tid & 63, wave = __builtin_amdgcn_readfirstlane(tid >> 6);
    const int G = gridDim.x, gw = blockIdx.x * NWAVES + wave, NGW = G * NWAVES, gtid = blockIdx.x * NTHREADS + tid, NT = G * NTHREADS;
    unsigned char* ws = args.ws;
    unsigned* ctl = (unsigned*)(ws + WS_CTL);
    for (int u = tid; u < (LDS_BYTES - RING_BYTES) / 4; u += NTHREADS) ((LAS unsigned*)(lds + RING_BYTES))[u] = 0u;
    __syncthreads();
#if ONE_LAUNCH
    XcdBarrier bar = xcd_barrier_post(ctl + 4096, MISC + 8);
#define GRID_BAR() xcd_barrier(bar)
#else
#define GRID_BAR() do {} while (0)
#endif
    const int lo = args.ph_lo, hi = args.ph_hi;
    int ph = 0;
#define IN_PH (lo <= ph && ph < hi)
#define SEAM() do { if (lo <= ph && ph + 1 < hi) GRID_BAR(); ++ph; } while (0)

    LAS float* scr = (LAS float*)(lds + wave * 16384);

#define PHASE(...) do { if (IN_PH) { __VA_ARGS__ } SEAM(); } while (0)
#define GEMM_SITE(EPI, Aptr, Bptr, NN, KK, LDA, ...) do { pg8::Gemm g{(const u16*)(Aptr), (const u16*)(Bptr), M, NN, KK, LDA}; pg8::StaticOrder S; S.init(M, NN, G, (int)blockIdx.x); \
        pg8::EPI E{__VA_ARGS__}; pg8::gemm_phase<pg8::EPI, pg8::StaticOrder, true>(lds, g, S, E); } while (0)
#define CONV_FFN(LBASE, F2BASE) do { \
        conv_matrix(args.in[LBASE + 2], DM, DFF, (u16*)(ws + W_GU1), DM, 1, scr, gw, NGW, lane); \
        conv_matrix(args.in[LBASE + 3], DM, DFF, (u16*)(ws + W_GU1), DM, 2, scr, gw, NGW, lane); \
        conv_matrix(args.in[LBASE + 4], DFF, DM, (u16*)(ws + W_D1), DFF, 0, scr, gw, NGW, lane); \
        conv_matrix(args.in[F2BASE + 2], DM, DFF, (u16*)(ws + W_GU2), DM, 1, scr, gw, NGW, lane); \
        conv_matrix(args.in[F2BASE + 3], DM, DFF, (u16*)(ws + W_GU2), DM, 2, scr, gw, NGW, lane); \
        conv_matrix(args.in[F2BASE + 4], DFF, DM, (u16*)(ws + W_D2), DFF, 0, scr, gw, NGW, lane); } while (0)
#define FFN_BLOCK(WGU, WD, POSTI, NEXTI, HASH) do { \
        PHASE( GEMM_SITE(EpiSwiglu, ws + WS_H, ws + WGU, NGU, DM, DM, (u16*)(ws + WS_ACT), DFF); ); \
        PHASE( GEMM_SITE(EpiF32, ws + WS_ACT, ws + WD, DM, DFF, DFF, (float*)(ws + WS_Y), DM); ); \
        PHASE( norm_rows<true, HASH>(args.out, (const float*)(ws + WS_Y), args.in[POSTI], 0.5f, args.out, HASH ? args.in[NEXTI] : nullptr, (u16*)(ws + WS_H), gw, NGW, lane); ); } while (0)
#define WOUT_BLOCK(POSTI, NEXTI) do { \
        PHASE( GEMM_SITE(EpiF32, ws + WS_H, ws + W_OUT, DM, DM, DM, (float*)(ws + WS_Y), DM); ); \
        PHASE( norm_rows<true, true>(args.out, (const float*)(ws + WS_Y), args.in[POSTI], 1.0f, args.out, args.in[NEXTI], (u16*)(ws + WS_H), gw, NGW, lane); ); } while (0)

    PHASE(
        CONV_FFN(I_L0, I_L0 + 14);
        conv_matrix(args.in[I_L0 + 7], DM, 1184, (u16*)(ws + W_IN), DM, 3, scr, gw, NGW, lane);
        zero_u32x4(ws + W_IN + (size_t)1184 * DM * 2, (size_t)(N0 - 1184) * DM * 2 / 16, gtid, NT);
        conv_matrix(args.in[I_L0 + 10], 256, 768, (u16*)(ws + W_UQ), 256, 5, scr, gw, NGW, lane);
        for (int i = gtid; i < 1024 * 16; i += NT) *(u32x4*)(ws + W_UKV + (size_t)(i >> 4) * 512 + 256 + (i & 15) * 16) = (u32x4){0u, 0u, 0u, 0u};
        conv_matrix(args.in[I_L0 + 12], 128, 1024, (u16*)(ws + W_UKV), 256, 0, scr, gw, NGW, lane);
        conv_matrix(args.in[I_L0 + 13], DM, DM, (u16*)(ws + W_OUT), DM, 0, scr, gw, NGW, lane);
        { float* BIAS = (float*)(ws + WS_BIAS); f32x2* ROPE = (f32x2*)(ws + WS_ROPE);
          for (int i = gtid; i < 24 * 2048; i += NT) { const int slot = i >> 11, d = i & 2047; BIAS[i] = args.in[I_REL][t5_bucket(d) * 24 + slot] * LOG2E; }
          for (int i = gtid; i < 2048 * 16; i += NT) { const int sp = i >> 4, jj = i & 15; const float inv = powf(10000.0f, -(float)(2 * jj) / 32.0f); const float ang = (float)sp * inv;
              ROPE[i] = (f32x2){(float)cos((double)ang), (float)sin((double)ang)}; } }
        norm_rows<false, true>(args.in[I_X], nullptr, nullptr, 0.f, args.out, args.in[I_L0 + 0], (u16*)(ws + WS_H), gw, NGW, lane);
    );
    FFN_BLOCK(W_GU1, W_D1, I_L0 + 1, I_L0 + 5, true);
    PHASE( GEMM_SITE(EpiF16, ws + WS_H, ws + W_IN, N0, DM, DM, (u16*)(ws + WS_Z), N0); );
    PHASE( mla_prep((const u16*)(ws + WS_Z), args.in[I_L0 + 9], args.in[I_L0 + 11], (const f32x2*)(ws + WS_ROPE), (u16*)(ws + WS_CQN), (u16*)(ws + WS_CKVN), (u16*)(ws + WS_KR), gw, NGW, lane); );
    PHASE( GEMM_SITE(EpiF16, ws + WS_CQN, ws + W_UQ, 768, 256, 256, (u16*)(ws + WS_QB), 768);
           GEMM_SITE(EpiF16, ws + WS_CKVN, ws + W_UKV, 1024, 256, 256, (u16*)(ws + WS_KVB), 1024); );
    PHASE( att::l0_attn(lds, (const u16*)(ws + WS_Z), (const u16*)(ws + WS_QB), (const u16*)(ws + WS_KVB), (const u16*)(ws + WS_KR), (const float*)(ws + WS_BIAS), (const f32x2*)(ws + WS_ROPE), args.in[I_L0 + 8], (u16*)(ws + WS_H), tid, wave, lane); );
    WOUT_BLOCK(I_L0 + 6, I_L0 + 14);
    FFN_BLOCK(W_GU2, W_D2, I_L0 + 15, I_L1 + 0, true);
    PHASE(
        CONV_FFN(I_L1, I_L1 + 15);
        conv_matrix(args.in[I_L1 + 7], DM, 2840, (u16*)(ws + W_IN), DM, 4, scr, gw, NGW, lane);
        zero_u32x4(ws + W_IN + (size_t)2840 * DM * 2, (size_t)(N1 - 2840) * DM * 2 / 16, gtid, NT);
        conv_matrix(args.in[I_L1 + 14], DM, DM, (u16*)(ws + W_OUT), DM, 0, scr, gw, NGW, lane);
        conv_matrix(args.in[I_L1 + 10], 2048, 256, (u16*)(ws + W_C1), 2048, 0, scr, gw, NGW, lane);
        conv_matrix(args.in[I_L1 + 12], 2048, 256, (u16*)(ws + W_C1) + 256 * 2048, 2048, 0, scr, gw, NGW, lane);
        for (int it = gw; it < 512; it += NGW) {
            const int sel = it >> 8, n = it & 255; const float* pe = args.in[I_L1 + 8 + sel]; const float* w1 = args.in[I_L1 + 10 + 2 * sel]; float sacc = 0.f;
            for (int mm = 0; mm < 32; ++mm) { const int k = lane + 64 * mm; sacc += pe[k] * w1[(size_t)k * 256 + n]; }
            sacc = wave_sum(sacc); if (lane == 0) ((float*)(ws + WS_PEB))[it] = sacc; }
    );
    FFN_BLOCK(W_GU1, W_D1, I_L1 + 1, I_L1 + 5, true);
    PHASE( GEMM_SITE(EpiF16, ws + WS_H, ws + W_IN, N1, DM, DM, (u16*)(ws + WS_Z), N1); );
    PHASE( att::l1_compress_hidden(lds, (const u16*)(ws + WS_Z), (const u16*)(ws + W_C1), (const float*)(ws + WS_PEB), (float*)(ws + WS_HID), (float*)(ws + WS_KMEAN), tid, wave, lane, gw, NGW); );
    PHASE( l1_compress_out((const float*)(ws + WS_HID), args.in[I_L1 + 11], args.in[I_L1 + 13], (float*)(ws + WS_KCMP), (float*)(ws + WS_VCMP), gw, NGW, lane); );
    PHASE( att::l1_cmp_attn(lds, (const u16*)(ws + WS_Z), (const float*)(ws + WS_KCMP), (const float*)(ws + WS_VCMP), (float*)(ws + WS_OCMP), (unsigned*)(ws + WS_SEL), tid, wave, lane);
           att::l1_moba_select((const u16*)(ws + WS_Z), (const float*)(ws + WS_KMEAN), (unsigned*)(ws + WS_MSEL), gtid, NT); );
    PHASE( att::l1_attn(lds, (const u16*)(ws + WS_Z), (const float*)(ws + WS_BIAS), (const unsigned*)(ws + WS_SEL), (const unsigned*)(ws + WS_MSEL), (const float*)(ws + WS_OCMP), (u16*)(ws + WS_H), tid, wave, lane); );
    WOUT_BLOCK(I_L1 + 6, I_L1 + 15);
    FFN_BLOCK(W_GU2, W_D2, I_L1 + 16, 0, false);
}

constexpr int N_PHASES = 64;
extern "C" void kernel_launch(void* const* d_in, const int* in_sizes, int n_in, void* d_out, int out_size, void* d_ws, size_t ws_size, hipStream_t stream) {
    static int grid = 0;
    if (grid == 0) {
        if (n_in != 41 || out_size != M * DM || ws_size < WS_END) { fprintf(stderr, "kernel_launch: unexpected shapes (n_in %d out %d ws %zu)\n", n_in, out_size, ws_size); grid = -1; return; }
        int dev = 0, cus = 0;
        if (hipGetDevice(&dev) != hipSuccess || hipDeviceGetAttribute(&cus, hipDeviceAttributeMultiprocessorCount, dev) != hipSuccess) { grid = -1; return; }
        if (hipFuncSetAttribute((const void*)fwd, hipFuncAttributeMaxDynamicSharedMemorySize, LDS_BYTES) != hipSuccess) { grid = -1; return; }
        int per_cu = 0;
        (void)hipOccupancyMaxActiveBlocksPerMultiprocessor(&per_cu, (const void*)fwd, NTHREADS, LDS_BYTES);
        (void)hipGetLastError();
        grid = cus;
    }
    if (grid < 0) return;
    (void)hipMemsetAsync((char*)d_ws + WS_CTL, 0, CTL_ZERO_BYTES, stream);
    Args a{};
    for (int i = 0; i < 41; ++i) a.in[i] = (const float*)d_in[i];
    a.out = (float*)d_out; a.ws = (unsigned char*)d_ws;
#if ONE_LAUNCH
    a.ph_lo = 0; a.ph_hi = N_PHASES;
    hipLaunchKernelGGL(fwd, dim3(grid), dim3(NTHREADS), LDS_BYTES, stream, a);
#else
    for (int p = 0; p < 28; ++p) { a.ph_lo = p; a.ph_hi = p + 1; hipLaunchKernelGGL(fwd, dim3(grid), dim3(NTHREADS), LDS_BYTES, stream, a); }
#endif
}
```
